# Optimizing an MI355X kernel written in HIP

```python
import math
import jax, jax.numpy as jnp
from jax import lax
import numpy as np

D_MODEL = 1024
BATCH = 8
SEQ = 2048
DEPTH = 2

N_MIXERS = 2
N_HEADS = 16
HEAD_DIM = 64
ATTN_WIDTH = N_HEADS * HEAD_DIM
FOX_BLOCK = 128
FOX_IN = 4 * ATTN_WIDTH + N_HEADS
NSA_GROUPS = 4
NSA_REP = N_HEADS // NSA_GROUPS
KV_WIDTH = NSA_GROUPS * HEAD_DIM
CMP_LEN = 32
CMP_STRIDE = 16
CMP_HIDDEN = 256
SEL_LEN = 64
N_SELECT = 8
SEL_QCHUNK = 32
WINDOW = 512
WIN_BLOCK = 128
N_BRANCH = 3
NSA_IN = 2 * ATTN_WIDTH + 6 * KV_WIDTH + N_BRANCH * N_HEADS
ROPE_THETA = 500000.0
ROPE_DIM = HEAD_DIM // 4
NORM_EPS = 1e-6
NEG = -1e30
FORCE = 1e6
N_FOX = (DEPTH + 1) // 2
N_NSA = DEPTH // 2

kernel_name = "fox_nsa_interleaved_hybrid"


def rmsnorm(x, g):
    xf = x.astype(jnp.float32)
    y = xf * lax.rsqrt(jnp.mean(xf * xf, axis=-1, keepdims=True) + NORM_EPS)
    return (y * g.astype(jnp.float32)).astype(x.dtype)


def rope_partial(x, pos):
    half = ROPE_DIM // 2
    inv_freq = jnp.power(ROPE_THETA, -jnp.arange(half, dtype=jnp.float32) * (2.0 / ROPE_DIM))
    ang = pos.astype(jnp.float32)[:, None] * inv_freq[None, :]
    shape = (pos.shape[0],) + (1,) * (x.ndim - 3) + (half,)
    cos = jnp.cos(ang).reshape(shape)
    sin = jnp.sin(ang).reshape(shape)
    xr = x[..., :ROPE_DIM].astype(jnp.float32)
    x1, x2 = xr[..., :half], xr[..., half:]
    rot = jnp.concatenate([x1 * cos - x2 * sin, x1 * sin + x2 * cos], axis=-1).astype(x.dtype)
    return jnp.concatenate([rot, x[..., ROPE_DIM:]], axis=-1)


def fox_mixer(h, w_in, b_f, w_out):
    B, S, _ = h.shape
    W = ATTN_WIDTH
    proj = h @ w_in
    q, k, v, f, z = jnp.split(proj, [W, 2 * W, 3 * W, 3 * W + N_HEADS], axis=-1)
    q = q.reshape(B, S, N_HEADS, HEAD_DIM)
    k = k.reshape(B, S, N_HEADS, HEAD_DIM)
    v = v.reshape(B, S, N_HEADS, HEAD_DIM)
    log_f = jax.nn.log_sigmoid(f.astype(jnp.float32) + b_f.astype(jnp.float32))
    c = jnp.cumsum(log_f, axis=1).transpose(0, 2, 1)
    scale = HEAD_DIM ** -0.5
    outs = []
    for qb in range(S // FOX_BLOCK):
        s0, s1 = qb * FOX_BLOCK, (qb + 1) * FOX_BLOCK
        logits = jnp.einsum('bqhd,bkhd->bhqk', q[:, s0:s1], k[:, :s1]).astype(jnp.float32) * scale
        logits = logits + c[:, :, s0:s1, None] - c[:, :, None, :s1]
        tq = jnp.arange(s0, s1)
        tk = jnp.arange(s1)
        logits = jnp.where(tk[None, :] <= tq[:, None], logits, NEG)
        p = jax.nn.softmax(logits, axis=-1).astype(v.dtype)
        outs.append(jnp.einsum('bhqk,bkhd->bqhd', p, v[:, :s1]))
    o = jnp.concatenate(outs, axis=1).reshape(B, S, W)
    return (o * jax.nn.silu(z)) @ w_out


def compress_blocks(x, pe, w1, w2):
    B, S, G, D = x.shape
    n_chunk = S // CMP_STRIDE
    r = CMP_LEN // CMP_STRIDE
    n_cmp = n_chunk - r + 1
    ch = x.reshape(B, n_chunk, CMP_STRIDE, G, D)
    blk = jnp.concatenate([ch[:, j:j + n_cmp] for j in range(r)], axis=2)
    blk = blk + pe[None, None, :, None, :]
    blk = blk.transpose(0, 1, 3, 2, 4).reshape(B, n_cmp, G, CMP_LEN * D)
    return jax.nn.silu(blk @ w1) @ w2


def nsa_mixer(h, w_in, pe_k, w_ck1, w_ck2, pe_v, w_cv1, w_cv2, w_out):
    B, S, _ = h.shape
    G, R, D, W = NSA_GROUPS, NSA_REP, HEAD_DIM, ATTN_WIDTH
    proj = h @ w_in
    offs = [W + i * KV_WIDTH for i in range(1, 7)] + [W + 6 * KV_WIDTH + N_BRANCH * N_HEADS]
    q, kc_raw, vc_raw, ks_raw, vs_raw, kw_raw, vw_raw, gate_raw, z = jnp.split(proj, [W] + offs, axis=-1)
    pos = jnp.arange(S)
    q = rope_partial(q.reshape(B, S, G, R, D), pos)
    scale = D ** -0.5

    kc = compress_blocks(kc_raw.reshape(B, S, G, D), pe_k, w_ck1, w_ck2)
    vc = compress_blocks(vc_raw.reshape(B, S, G, D), pe_v, w_cv1, w_cv2)
    n_cmp = kc.shape[1]
    cmp_end = jnp.arange(n_cmp) * CMP_STRIDE + CMP_LEN - 1
    kc = rope_partial(kc, cmp_end)
    lg_c = jnp.einsum('bsgrd,bcgd->bgrsc', q, kc).astype(jnp.float32) * scale
    mask_c = cmp_end[None, :] <= pos[:, None]
    p_c = jax.nn.softmax(jnp.where(mask_c, lg_c, NEG), axis=-1)
    p_c = jnp.where(mask_c, p_c, 0.0)
    o_c = jnp.einsum('bgrsc,bcgd->bsgrd', p_c.astype(vc.dtype), vc)

    n_sel_blk = S // SEL_LEN
    n_sel = min(N_SELECT, n_sel_blk)
    ci = jnp.arange(n_cmp) * CMP_STRIDE
    sj = jnp.arange(n_sel_blk) * SEL_LEN
    overlap = ((ci[:, None] < sj[None, :] + SEL_LEN) & (ci[:, None] + CMP_LEN > sj[None, :])).astype(jnp.float32)
    imp = jnp.einsum('bgsc,cj->bgsj', p_c.sum(axis=2), overlap)
    cur = pos // SEL_LEN
    blk_ids = jnp.arange(n_sel_blk)
    forced = (blk_ids[None, :] == 0) | (blk_ids[None, :] == cur[:, None]) | (blk_ids[None, :] == cur[:, None] - 1)
    causal = blk_ids[None, :] <= cur[:, None]
    imp = jnp.where(forced, FORCE, jnp.where(causal, imp, -1.0))
    _, idx = lax.top_k(imp, n_sel)

    ks = rope_partial(ks_raw.reshape(B, S, G, D), pos)
    vs = vs_raw.reshape(B, S, G, D)
    k_blocks = ks.reshape(B, n_sel_blk, SEL_LEN, G, D).transpose(0, 3, 1, 2, 4)
    v_blocks = vs.reshape(B, n_sel_blk, SEL_LEN, G, D).transpose(0, 3, 1, 2, 4)
    n_qc = S // SEL_QCHUNK
    q_ch = q.reshape(B, n_qc, SEL_QCHUNK, G, R, D).transpose(1, 0, 2, 3, 4, 5)
    idx_ch = idx.transpose(0, 2, 1, 3).reshape(B, n_qc, SEL_QCHUNK, G, n_sel).transpose(1, 0, 2, 3, 4)
    pos_ch = pos.reshape(n_qc, SEL_QCHUNK)
    bi = jnp.arange(B)[:, None, None, None]
    gi = jnp.arange(G)[None, None, :, None]
    l_off = jnp.arange(SEL_LEN)

    def sel_chunk(args):
        qc, ic, tc = args
        kb = k_blocks[bi, gi, ic]
        vb = v_blocks[bi, gi, ic]
        lg = jnp.einsum('btgrd,btgnld->btgrnl', qc, kb).astype(jnp.float32) * scale
        kpos = ic[..., None] * SEL_LEN + l_off
        m = (kpos <= tc[None, :, None, None, None])[:, :, :, None]
        lg = jnp.where(m, lg, NEG)
        p = jax.nn.softmax(lg.reshape(B, SEL_QCHUNK, G, R, n_sel * SEL_LEN), axis=-1)
        p = p.reshape(B, SEL_QCHUNK, G, R, n_sel, SEL_LEN).astype(vb.dtype)
        return jnp.einsum('btgrnl,btgnld->btgrd', p, vb)

    o_s = lax.map(sel_chunk, (q_ch, idx_ch, pos_ch))
    o_s = o_s.transpose(1, 0, 2, 3, 4, 5).reshape(B, S, G, R, D)

    kw = rope_partial(kw_raw.reshape(B, S, G, D), pos)
    vw = vw_raw.reshape(B, S, G, D)
    n_qb = S // WIN_BLOCK
    n_wb = -(-WINDOW // WIN_BLOCK)
    pad = n_wb * WIN_BLOCK
    band = (n_wb + 1) * WIN_BLOCK
    kpad = jnp.pad(kw, ((0, 0), (pad, 0), (0, 0), (0, 0))).reshape(B, n_qb + n_wb, WIN_BLOCK, G, D)
    vpad = jnp.pad(vw, ((0, 0), (pad, 0), (0, 0), (0, 0))).reshape(B, n_qb + n_wb, WIN_BLOCK, G, D)
    k_band = jnp.concatenate([kpad[:, j:j + n_qb] for j in range(n_wb + 1)], axis=2)
    v_band = jnp.concatenate([vpad[:, j:j + n_qb] for j in range(n_wb + 1)], axis=2)
    qb = q.reshape(B, n_qb, WIN_BLOCK, G, R, D)
    lg_w = jnp.einsum('bnqgrd,bnkgd->bngrqk', qb, k_band).astype(jnp.float32) * scale
    tq = pos.reshape(n_qb, WIN_BLOCK)
    tk = jnp.arange(n_qb)[:, None] * WIN_BLOCK - pad + jnp.arange(band)[None, :]
    m_w = (tk[:, None, :] <= tq[:, :, None]) & (tk[:, None, :] > tq[:, :, None] - WINDOW) & (tk[:, None, :] >= 0)
    lg_w = jnp.where(m_w[None, :, None, None], lg_w, NEG)
    p_w = jax.nn.softmax(lg_w, axis=-1).astype(v_band.dtype)
    o_w = jnp.einsum('bngrqk,bnkgd->bnqgrd', p_w, v_band).reshape(B, S, G, R, D)

    g = jax.nn.sigmoid(gate_raw.astype(jnp.float32)).reshape(B, S, G, R, N_BRANCH).astype(o_c.dtype)
    o = g[..., 0:1] * o_c + g[..., 1:2] * o_s + g[..., 2:3] * o_w
    return (o.reshape(B, S, W) * jax.nn.silu(z)) @ w_out


def setup_inputs(seed: int = 0) -> dict:
    key = jax.random.key(seed)
    ks = jax.random.split(key, 16)
    f32 = jnp.float32
    W = ATTN_WIDTH
    cdim = CMP_LEN * HEAD_DIM
    return {
        "x": jax.random.normal(ks[0], (BATCH, SEQ, D_MODEL), f32),
        "norm_g": 1.0 + 0.1 * jax.random.normal(ks[1], (DEPTH, D_MODEL), f32),
        "fox_w_in": jax.random.normal(ks[2], (N_FOX, D_MODEL, FOX_IN), f32) * D_MODEL ** -0.5,
        "fox_b_f": jax.random.uniform(ks[3], (N_FOX, N_HEADS), f32, 1.0, 6.0),
        "fox_w_out": jax.random.normal(ks[4], (N_FOX, W, D_MODEL), f32) * W ** -0.5,
        "nsa_w_in": jax.random.normal(ks[5], (N_NSA, D_MODEL, NSA_IN), f32) * D_MODEL ** -0.5,
        "nsa_pe_k": 0.1 * jax.random.normal(ks[6], (N_NSA, CMP_LEN, HEAD_DIM), f32),
        "nsa_w_ck1": jax.random.normal(ks[7], (N_NSA, cdim, CMP_HIDDEN), f32) * cdim ** -0.5,
        "nsa_w_ck2": jax.random.normal(ks[8], (N_NSA, CMP_HIDDEN, HEAD_DIM), f32) * CMP_HIDDEN ** -0.5,
        "nsa_pe_v": 0.1 * jax.random.normal(ks[9], (N_NSA, CMP_LEN, HEAD_DIM), f32),
        "nsa_w_cv1": jax.random.normal(ks[10], (N_NSA, cdim, CMP_HIDDEN), f32) * cdim ** -0.5,
        "nsa_w_cv2": jax.random.normal(ks[11], (N_NSA, CMP_HIDDEN, HEAD_DIM), f32) * CMP_HIDDEN ** -0.5,
        "nsa_w_out": jax.random.normal(ks[12], (N_NSA, W, D_MODEL), f32) * W ** -0.5,
        "final_g": 1.0 + 0.1 * jax.random.normal(ks[13], (D_MODEL,), f32),
    }


def reference(x, norm_g, fox_w_in, fox_b_f, fox_w_out, nsa_w_in, nsa_pe_k, nsa_w_ck1, nsa_w_ck2,
              nsa_pe_v, nsa_w_cv1, nsa_w_cv2, nsa_w_out, final_g):
    for i in range(DEPTH):
        h = rmsnorm(x, norm_g[i])
        j = i // N_MIXERS
        if i % N_MIXERS == 0:
            y = fox_mixer(h, fox_w_in[j], fox_b_f[j], fox_w_out[j])
        else:
            y = nsa_mixer(h, nsa_w_in[j], nsa_pe_k[j], nsa_w_ck1[j], nsa_w_ck2[j],
                          nsa_pe_v[j], nsa_w_cv1[j], nsa_w_cv2[j], nsa_w_out[j])
        x = x + y
    return rmsnorm(x, final_g)
```

```cpp
#include <hip/hip_runtime.h>
#include <hip/hip_cooperative_groups.h>
#include <cstdio>
#include <cstdint>
namespace cg = cooperative_groups;

typedef unsigned short bf16_t;
typedef unsigned int u32;

constexpr int DM = 1024, BATCH = 8, SEQ = 2048, MTOK = BATCH * SEQ;
constexpr int NH = 16, HD = 64;
constexpr int FOX_IN = 4 * DM + NH;
constexpr int NSA_IN = 3632;
constexpr int N0 = 4096;
constexpr int N1 = 3840;
constexpr int C1_Q = 0, C1_KC = 1024, C1_VC = 1280, C1_KS = 1536, C1_VS = 1792, C1_KW = 2048, C1_VW = 2304, C1_Z = 2560, C1_GATE = 3584;
constexpr int NCMP = 127, NCMP_P = 128;
constexpr float EPS = 1e-6f;

constexpr size_t MiB = 1u << 20;
constexpr size_t WS_CTL = 0;
constexpr size_t WS_W0T = 1 * MiB;
constexpr size_t WS_WO0T = 9 * MiB;
constexpr size_t WS_W1T = 11 * MiB;
constexpr size_t WS_WO1T = 19 * MiB;
constexpr size_t WS_WCK1T = 21 * MiB;
constexpr size_t WS_WCV1T = 22 * MiB;
constexpr size_t WS_WCK2T = 23 * MiB;
constexpr size_t WS_WCV2T = 23 * MiB + 65536;
constexpr size_t WS_CBIAS = 23 * MiB + 131072;
constexpr size_t WS_ROPE = 23 * MiB + 196608;
constexpr size_t WS_RS0 = 24 * MiB;
constexpr size_t WS_RS1 = 24 * MiB + 65536;
constexpr size_t WS_LOGF = 25 * MiB;
constexpr size_t WS_CUM = 26 * MiB;
constexpr size_t WS_KC = 27 * MiB;
constexpr size_t WS_VC = 27 * MiB + 524288;
constexpr size_t WS_HID = 28 * MiB;
constexpr size_t WS_XB = 32 * MiB;
constexpr size_t WS_ACT = 64 * MiB;
constexpr size_t WS_AO = 192 * MiB;
constexpr size_t WS_END = 224 * MiB;

struct Params { const float* in[14]; float* out; unsigned char* ws; };

__device__ __forceinline__ float bf2f(bf16_t v) { return __uint_as_float((u32)v << 16); }
__device__ __forceinline__ bf16_t f2bf(float f) { u32 u = __float_as_uint(f); return (bf16_t)((u + 0x7fffu + ((u >> 16) & 1u)) >> 16); }
__device__ __forceinline__ float lo_f(u32 w) { return __uint_as_float(w << 16); }
__device__ __forceinline__ float hi_f(u32 w) { return __uint_as_float(w & 0xffff0000u); }
__device__ __forceinline__ float wave_sum(float v) {
#pragma unroll
    for (int o = 1; o < 64; o <<= 1) v += __shfl_xor(v, o);
    return v;
}
__device__ __forceinline__ float wave_max(float v) {
#pragma unroll
    for (int o = 1; o < 64; o <<= 1) v = fmaxf(v, __shfl_xor(v, o));
    return v;
}
__device__ __forceinline__ float sigmoidf_(float x) { return 1.f / (1.f + __expf(-x)); }
__device__ __forceinline__ float dot64(const bf16_t* qu, const bf16_t* kp) {
    float s = 0.f;
#pragma unroll
    for (int i = 0; i < 8; ++i) {
        const uint4 a = ((const uint4*)qu)[i], b = ((const uint4*)kp)[i];
        s += lo_f(a.x) * lo_f(b.x); s += hi_f(a.x) * hi_f(b.x);
        s += lo_f(a.y) * lo_f(b.y); s += hi_f(a.y) * hi_f(b.y);
        s += lo_f(a.z) * lo_f(b.z); s += hi_f(a.z) * hi_f(b.z);
        s += lo_f(a.w) * lo_f(b.w); s += hi_f(a.w) * hi_f(b.w);
    }
    return s;
}

struct APlain { const bf16_t* A; int lda; __device__ __forceinline__ const bf16_t* operator()(int m, int k) const { return A + (size_t)m * lda + k; } };
struct ACmp { const bf16_t* act; int col0; __device__ __forceinline__ const bf16_t* operator()(int m, int k) const {
    const int g = m & 3, c0 = (m >> 2) & 127, b = m >> 9; const int c = c0 > 126 ? 126 : c0; const int l = k >> 6, d = k & 63;
    return act + (size_t)(b * SEQ + 16 * c + l) * N1 + col0 + g * 64 + d; } };

template <class AF, class Epi>
__device__ __forceinline__ void gemm_simple(const AF& af, const bf16_t* Bt, int ldb, int M, int N, int K, float* lds, const Epi& epi) {
    float* As = lds;
    float* Bs = lds + 128 * 33;
    const int tid = threadIdx.x, r = tid & 127, cgp = tid >> 7;
    const int tilesN = N / 64, ntiles = (M / 128) * tilesN;
    for (int tile = blockIdx.x; tile < ntiles; tile += gridDim.x) {
        const int tm = tile / tilesN, tn = tile % tilesN;
        float acc[16];
#pragma unroll
        for (int j = 0; j < 16; ++j) acc[j] = 0.f;
        for (int k0 = 0; k0 < K; k0 += 32) {
            __syncthreads();
            { const int ar = tid >> 2, ak = (tid & 3) * 8; const uint4 v = *(const uint4*)af(tm * 128 + ar, k0 + ak); float* d = As + ar * 33 + ak;
              d[0] = lo_f(v.x); d[1] = hi_f(v.x); d[2] = lo_f(v.y); d[3] = hi_f(v.y); d[4] = lo_f(v.z); d[5] = hi_f(v.z); d[6] = lo_f(v.w); d[7] = hi_f(v.w); }
            if (tid < 256) { const int bn = tid >> 2, bk = (tid & 3) * 8; const uint4 v = *(const uint4*)(Bt + (size_t)(tn * 64 + bn) * ldb + k0 + bk); float* d = Bs + bk * 64 + bn;
              d[0] = lo_f(v.x); d[64] = hi_f(v.x); d[128] = lo_f(v.y); d[192] = hi_f(v.y); d[256] = lo_f(v.z); d[320] = hi_f(v.z); d[384] = lo_f(v.w); d[448] = hi_f(v.w); }
            __syncthreads();
#pragma unroll 4
            for (int kk = 0; kk < 32; ++kk) {
                const float a = As[r * 33 + kk]; const float* bp = Bs + kk * 64 + cgp * 16;
#pragma unroll
                for (int j = 0; j < 16; ++j) acc[j] += a * bp[j];
            }
        }
        epi(tm * 128 + r, tn * 64 + cgp * 16, acc);
    }
}

__global__ void __launch_bounds__(512) fwd_kernel(Params p) {
    extern __shared__ __attribute__((aligned(16))) unsigned char lds_raw[];
    float* ldsf = (float*)lds_raw;
    cg::grid_group grid = cg::this_grid();
    const int tid = threadIdx.x, lane = tid & 63, wib = tid >> 6;
    const int gtid = blockIdx.x * 512 + tid, gsz = gridDim.x * 512;
    const int gwave = blockIdx.x * 8 + wib, nwaves = gridDim.x * 8;

    const float* x = p.in[0]; const float* norm_g = p.in[1]; const float* fox_w_in = p.in[2]; const float* fox_b_f = p.in[3]; const float* fox_w_out = p.in[4];
    const float* nsa_w_in = p.in[5]; const float* pe_k = p.in[6]; const float* w_ck1 = p.in[7]; const float* w_ck2 = p.in[8];
    const float* pe_v = p.in[9]; const float* w_cv1 = p.in[10]; const float* w_cv2 = p.in[11]; const float* nsa_w_out = p.in[12]; const float* final_g = p.in[13];
    float* out = p.out; unsigned char* ws = p.ws;
    bf16_t* W0T = (bf16_t*)(ws + WS_W0T); bf16_t* WO0T = (bf16_t*)(ws + WS_WO0T); bf16_t* W1T = (bf16_t*)(ws + WS_W1T); bf16_t* WO1T = (bf16_t*)(ws + WS_WO1T);
    bf16_t* WCK1T = (bf16_t*)(ws + WS_WCK1T); bf16_t* WCV1T = (bf16_t*)(ws + WS_WCV1T); bf16_t* WCK2T = (bf16_t*)(ws + WS_WCK2T); bf16_t* WCV2T = (bf16_t*)(ws + WS_WCV2T);
    float* CBIAS = (float*)(ws + WS_CBIAS); float* ROPE = (float*)(ws + WS_ROPE); float* RS0 = (float*)(ws + WS_RS0); float* RS1 = (float*)(ws + WS_RS1);
    float* LOGF = (float*)(ws + WS_LOGF); float* CUM = (float*)(ws + WS_CUM);
    bf16_t* KC = (bf16_t*)(ws + WS_KC); bf16_t* VC = (bf16_t*)(ws + WS_VC); bf16_t* HID = (bf16_t*)(ws + WS_HID);
    bf16_t* XB = (bf16_t*)(ws + WS_XB); bf16_t* ACT = (bf16_t*)(ws + WS_ACT); bf16_t* AO = (bf16_t*)(ws + WS_AO);
    const float* g0 = norm_g; const float* g1 = norm_g + DM;

    for (int i = gtid; i < N0 * DM; i += gsz) { const int k = i / N0, n = i % N0; const int col = n < 3072 ? n : n + 16; W0T[(size_t)n * DM + k] = f2bf(g0[k] * fox_w_in[(size_t)k * FOX_IN + col]); }
    for (int i = gtid; i < N1 * DM; i += gsz) { const int k = i / N1, n = i % N1; float v = 0.f;
        if (n < C1_Z) v = nsa_w_in[(size_t)k * NSA_IN + n]; else if (n < C1_GATE) v = nsa_w_in[(size_t)k * NSA_IN + n + 48]; else if (n < C1_GATE + 48) v = nsa_w_in[(size_t)k * NSA_IN + n - 1024];
        W1T[(size_t)n * DM + k] = f2bf(g1[k] * v); }
    for (int i = gtid; i < DM * DM; i += gsz) { const int k = i / DM, n = i % DM; WO0T[(size_t)n * DM + k] = f2bf(fox_w_out[i]); WO1T[(size_t)n * DM + k] = f2bf(nsa_w_out[i]); }
    for (int i = gtid; i < 2048 * 256; i += gsz) { const int k = i / 256, n = i % 256; WCK1T[(size_t)n * 2048 + k] = f2bf(w_ck1[i]); WCV1T[(size_t)n * 2048 + k] = f2bf(w_cv1[i]); }
    for (int i = gtid; i < 256 * 64; i += gsz) { const int k = i / 64, n = i % 64; WCK2T[n * 256 + k] = f2bf(w_ck2[i]); WCV2T[n * 256 + k] = f2bf(w_cv2[i]); }
    for (int i = gtid; i < SEQ * 8; i += gsz) { const int pos = i >> 3, j = i & 7; const double inv = pow(500000.0, -(double)j / 8.0); const double a = (double)pos * inv;
        ROPE[pos * 16 + j] = (float)cos(a); ROPE[pos * 16 + 8 + j] = (float)sin(a); }
    for (int o = gwave; o < 512; o += nwaves) { const int kv = o >> 8, n = o & 255; const float* pe = kv ? pe_v : pe_k; const float* w1 = kv ? w_cv1 : w_ck1; float s = 0.f;
        for (int k = lane; k < 2048; k += 64) s += pe[k] * w1[(size_t)k * 256 + n];
        s = wave_sum(s); if (lane == 0) CBIAS[o] = s; }
    for (int row = gwave; row < MTOK; row += nwaves) {
        const float* xr = x + (size_t)row * DM; float4 v[4]; float ss = 0.f;
#pragma unroll
        for (int j = 0; j < 4; ++j) { v[j] = *(const float4*)(xr + j * 256 + lane * 4); ss += v[j].x * v[j].x + v[j].y * v[j].y + v[j].z * v[j].z + v[j].w * v[j].w; }
        ss = wave_sum(ss); const float rstd = rsqrtf(ss * (1.f / DM) + EPS);
        if (lane == 0) RS0[row] = rstd;
#pragma unroll
        for (int j = 0; j < 4; ++j) { uint2 w; w.x = (u32)f2bf(v[j].x) | ((u32)f2bf(v[j].y) << 16); w.y = (u32)f2bf(v[j].z) | ((u32)f2bf(v[j].w) << 16); *(uint2*)(XB + (size_t)row * DM + j * 256 + lane * 4) = w; }
        for (int h = 0; h < NH; ++h) { float s = 0.f;
#pragma unroll
            for (int j = 0; j < 4; ++j) { const int k = j * 256 + lane * 4; const float4 gg = *(const float4*)(g0 + k);
                s += v[j].x * gg.x * fox_w_in[(size_t)(k + 0) * FOX_IN + 3072 + h]; s += v[j].y * gg.y * fox_w_in[(size_t)(k + 1) * FOX_IN + 3072 + h];
                s += v[j].z * gg.z * fox_w_in[(size_t)(k + 2) * FOX_IN + 3072 + h]; s += v[j].w * gg.w * fox_w_in[(size_t)(k + 3) * FOX_IN + 3072 + h]; }
            s = wave_sum(s); const float f = s * rstd + fox_b_f[h];
            if (lane == 0) LOGF[row * 16 + h] = fminf(f, 0.f) - log1pf(expf(-fabsf(f))); }
    }
    grid.sync();

    { APlain af{XB, DM};
      auto epi = [&](int row, int col0, const float (&acc)[16]) { const float rs = RS0[row]; u32 w[8];
#pragma unroll
          for (int j = 0; j < 8; ++j) w[j] = (u32)f2bf(acc[2 * j] * rs) | ((u32)f2bf(acc[2 * j + 1] * rs) << 16);
          uint4* d = (uint4*)(ACT + (size_t)row * N0 + col0); d[0] = make_uint4(w[0], w[1], w[2], w[3]); d[1] = make_uint4(w[4], w[5], w[6], w[7]); };
      gemm_simple(af, W0T, DM, MTOK, N0, DM, ldsf, epi); }
    for (int bh = gwave; bh < BATCH * NH; bh += nwaves) { const int b = bh >> 4, h = bh & 15; float loc = 0.f;
        for (int i = 0; i < 32; ++i) loc += LOGF[(size_t)(b * SEQ + lane * 32 + i) * 16 + h];
        float inc = loc;
#pragma unroll
        for (int o = 1; o < 64; o <<= 1) { const float t = __shfl_up(inc, o); if (lane >= o) inc += t; }
        float run = inc - loc;
        for (int i = 0; i < 32; ++i) { run += LOGF[(size_t)(b * SEQ + lane * 32 + i) * 16 + h]; CUM[(size_t)bh * SEQ + lane * 32 + i] = run; } }
    grid.sync();

    for (int task = gwave; task < BATCH * NH * (SEQ / 64); task += nwaves) {
        const int bh = task >> 5, tb = task & 31, b = bh >> 4, h = bh & 15, t = tb * 64 + lane; const size_t row = (size_t)b * SEQ + t;
        float q[64], o[64];
        { const uint4* qp = (const uint4*)(ACT + row * N0 + h * 64);
#pragma unroll
          for (int i = 0; i < 8; ++i) { const uint4 a = qp[i]; q[8 * i] = lo_f(a.x); q[8 * i + 1] = hi_f(a.x); q[8 * i + 2] = lo_f(a.y); q[8 * i + 3] = hi_f(a.y); q[8 * i + 4] = lo_f(a.z); q[8 * i + 5] = hi_f(a.z); q[8 * i + 6] = lo_f(a.w); q[8 * i + 7] = hi_f(a.w); } }
#pragma unroll
        for (int d = 0; d < 64; ++d) o[d] = 0.f;
        const float ct = CUM[(size_t)bh * SEQ + t]; float m = -1e30f, l = 0.f; const int smax = tb * 64 + 63;
        for (int s = 0; s <= smax; ++s) {
            const bf16_t* kr = ACT + ((size_t)b * SEQ + s) * N0 + 1024 + h * 64; const bf16_t* vr = kr + 1024; float dot = 0.f;
#pragma unroll
            for (int i = 0; i < 8; ++i) { const uint4 a = ((const uint4*)kr)[i];
                dot += q[8 * i] * lo_f(a.x) + q[8 * i + 1] * hi_f(a.x) + q[8 * i + 2] * lo_f(a.y) + q[8 * i + 3] * hi_f(a.y) + q[8 * i + 4] * lo_f(a.z) + q[8 * i + 5] * hi_f(a.z) + q[8 * i + 6] * lo_f(a.w) + q[8 * i + 7] * hi_f(a.w); }
            const float lg = dot * 0.125f + ct - CUM[(size_t)bh * SEQ + s];
            if (s <= t) { const float mn = fmaxf(m, lg), al = __expf(m - mn), pp = __expf(lg - mn); l = l * al + pp; m = mn;
#pragma unroll
                for (int i = 0; i < 8; ++i) { const uint4 a = ((const uint4*)vr)[i];
                    o[8 * i] = o[8 * i] * al + pp * lo_f(a.x); o[8 * i + 1] = o[8 * i + 1] * al + pp * hi_f(a.x); o[8 * i + 2] = o[8 * i + 2] * al + pp * lo_f(a.y); o[8 * i + 3] = o[8 * i + 3] * al + pp * hi_f(a.y);
                    o[8 * i + 4] = o[8 * i + 4] * al + pp * lo_f(a.z); o[8 * i + 5] = o[8 * i + 5] * al + pp * hi_f(a.z); o[8 * i + 6] = o[8 * i + 6] * al + pp * lo_f(a.w); o[8 * i + 7] = o[8 * i + 7] * al + pp * hi_f(a.w); } }
        }
        const float il = 1.f / l; const uint4* zp = (const uint4*)(ACT + row * N0 + 3072 + h * 64); uint4* op = (uint4*)(AO + row * DM + h * 64);
#pragma unroll
        for (int i = 0; i < 8; ++i) { const uint4 a = zp[i]; float z[8] = {lo_f(a.x), hi_f(a.x), lo_f(a.y), hi_f(a.y), lo_f(a.z), hi_f(a.z), lo_f(a.w), hi_f(a.w)}; u32 w[4];
#pragma unroll
            for (int e = 0; e < 4; ++e) { const float a0 = o[8 * i + 2 * e] * il * z[2 * e] * sigmoidf_(z[2 * e]), a1 = o[8 * i + 2 * e + 1] * il * z[2 * e + 1] * sigmoidf_(z[2 * e + 1]); w[e] = (u32)f2bf(a0) | ((u32)f2bf(a1) << 16); }
            op[i] = make_uint4(w[0], w[1], w[2], w[3]); }
    }
    grid.sync();

    { APlain af{AO, DM};
      auto epi = [&](int row, int col0, const float (&acc)[16]) { const float* xr = x + (size_t)row * DM + col0; float* orow = out + (size_t)row * DM + col0; u32 w[8]; float v[16];
#pragma unroll
          for (int j = 0; j < 16; ++j) { v[j] = xr[j] + acc[j]; orow[j] = v[j]; }
#pragma unroll
          for (int j = 0; j < 8; ++j) w[j] = (u32)f2bf(v[2 * j]) | ((u32)f2bf(v[2 * j + 1]) << 16);
          uint4* d = (uint4*)(XB + (size_t)row * DM + col0); d[0] = make_uint4(w[0], w[1], w[2], w[3]); d[1] = make_uint4(w[4], w[5], w[6], w[7]); };
      gemm_simple(af, WO0T, DM, MTOK, DM, DM, ldsf, epi); }
    grid.sync();
    for (int row = gwave; row < MTOK; row += nwaves) { const float* xr = out + (size_t)row * DM; float ss = 0.f;
#pragma unroll
        for (int j = 0; j < 4; ++j) { const float4 v = *(const float4*)(xr + j * 256 + lane * 4); ss += v.x * v.x + v.y * v.y + v.z * v.z + v.w * v.w; }
        ss = wave_sum(ss); if (lane == 0) RS1[row] = rsqrtf(ss * (1.f / DM) + EPS); }
    grid.sync();

    { APlain af{XB, DM};
      auto epi = [&](int row, int col0, const float (&acc)[16]) { const float rs = RS1[row]; float v[16];
#pragma unroll
          for (int j = 0; j < 16; ++j) v[j] = acc[j] * rs;
          const bool roped = (col0 < C1_KC) || (col0 >= C1_KS && col0 < C1_VS) || (col0 >= C1_KW && col0 < C1_VW);
          if (roped && (col0 & 63) == 0) { const float* rp = ROPE + (row & (SEQ - 1)) * 16;
#pragma unroll
              for (int i = 0; i < 8; ++i) { const float c = rp[i], s = rp[8 + i], x1 = v[i], x2 = v[i + 8]; v[i] = x1 * c - x2 * s; v[i + 8] = x1 * s + x2 * c; } }
          u32 w[8];
#pragma unroll
          for (int j = 0; j < 8; ++j) w[j] = (u32)f2bf(v[2 * j]) | ((u32)f2bf(v[2 * j + 1]) << 16);
          uint4* d = (uint4*)(ACT + (size_t)row * N1 + col0); d[0] = make_uint4(w[0], w[1], w[2], w[3]); d[1] = make_uint4(w[4], w[5], w[6], w[7]); };
      gemm_simple(af, W1T, DM, MTOK, N1, DM, ldsf, epi); }
    grid.sync();

    for (int kv = 0; kv < 2; ++kv) { ACmp af{ACT, kv ? C1_VC : C1_KC}; const float* cb = CBIAS + kv * 256; bf16_t* hid = HID + (size_t)kv * 4096 * 256;
      auto epi = [&](int row, int col0, const float (&acc)[16]) { u32 w[8];
#pragma unroll
          for (int j = 0; j < 8; ++j) { const float a0 = acc[2 * j] + cb[col0 + 2 * j], a1 = acc[2 * j + 1] + cb[col0 + 2 * j + 1]; w[j] = (u32)f2bf(a0 * sigmoidf_(a0)) | ((u32)f2bf(a1 * sigmoidf_(a1)) << 16); }
          uint4* d = (uint4*)(hid + (size_t)row * 256 + col0); d[0] = make_uint4(w[0], w[1], w[2], w[3]); d[1] = make_uint4(w[4], w[5], w[6], w[7]); };
      gemm_simple(af, kv ? WCV1T : WCK1T, 2048, 4096, 256, 2048, ldsf, epi); }
    grid.sync();
    for (int kv = 0; kv < 2; ++kv) { APlain af{HID + (size_t)kv * 4096 * 256, 256}; bf16_t* dst = kv ? VC : KC;
      auto epi = [&](int row, int col0, const float (&acc)[16]) { float v[16];
#pragma unroll
          for (int j = 0; j < 16; ++j) v[j] = acc[j];
          const int c = (row >> 2) & 127;
          if (kv == 0 && col0 == 0 && c < NCMP) { const float* rp = ROPE + (16 * c + 31) * 16;
#pragma unroll
              for (int i = 0; i < 8; ++i) { const float cc = rp[i], s = rp[8 + i], x1 = v[i], x2 = v[i + 8]; v[i] = x1 * cc - x2 * s; v[i + 8] = x1 * s + x2 * cc; } }
          u32 w[8];
#pragma unroll
          for (int j = 0; j < 8; ++j) w[j] = (u32)f2bf(v[2 * j]) | ((u32)f2bf(v[2 * j + 1]) << 16);
          uint4* d = (uint4*)(dst + (size_t)row * 64 + col0); d[0] = make_uint4(w[0], w[1], w[2], w[3]); d[1] = make_uint4(w[4], w[5], w[6], w[7]); };
      gemm_simple(af, kv ? WCV2T : WCK2T, 256, 4096, 64, 256, ldsf, epi); }
    grid.sync();

    { volatile float* sc = (volatile float*)(ldsf + wib * 128);
      for (int task = gwave; task < MTOK * 4; task += nwaves) {
        const int row = task >> 2, g = task & 3, b = row >> 11, t = row & (SEQ - 1), cur = t >> 6;
        const bf16_t* prow = ACT + (size_t)row * N1;
        int nvalid = (t >= 31) ? ((t - 31) >> 4) + 1 : 0; if (nvalid > NCMP) nvalid = NCMP;
        float psum0 = 0.f, psum1 = 0.f, oc[4], os[4], ow[4];
#pragma unroll
        for (int r = 0; r < 4; ++r) { const bf16_t* qp = prow + (g * 4 + r) * 64; float lg0 = -1e30f, lg1 = -1e30f;
            if (lane < nvalid) lg0 = 0.125f * dot64(qp, KC + ((size_t)(b * 128 + lane) * 4 + g) * 64);
            if (lane + 64 < nvalid) lg1 = 0.125f * dot64(qp, KC + ((size_t)(b * 128 + lane + 64) * 4 + g) * 64);
            const float mx = wave_max(fmaxf(lg0, lg1));
            float p0 = (lane < nvalid) ? __expf(lg0 - mx) : 0.f, p1 = (lane + 64 < nvalid) ? __expf(lg1 - mx) : 0.f;
            const float sm = wave_sum(p0 + p1); const float inv = nvalid > 0 ? 1.f / sm : 0.f; p0 *= inv; p1 *= inv; psum0 += p0; psum1 += p1;
            float acc = 0.f;
            for (int c = 0; c < nvalid; ++c) { const float pc = __shfl(c < 64 ? p0 : p1, c & 63); acc += pc * bf2f(VC[((size_t)(b * 128 + c) * 4 + g) * 64 + lane]); }
            oc[r] = acc; }
        sc[lane] = psum0; sc[64 + lane] = psum1;
        asm volatile("s_waitcnt lgkmcnt(0)" ::: "memory");
        const int j = lane & 31; float imp = 0.f;
#pragma unroll
        for (int e = -1; e <= 3; ++e) { const int c = 4 * j + e; if (c >= 0 && c < NCMP) imp += sc[c]; }
        asm volatile("s_waitcnt lgkmcnt(0)" ::: "memory");
        const bool forced = (j == 0) || (j == cur) || (j == cur - 1); const bool causal = j <= cur;
        const float val = forced ? 1e6f : (causal ? imp : -1.f);
        int rank = 0;
        for (int jj = 0; jj < 32; ++jj) { const float vj = __shfl(val, jj); rank += ((vj > val) || (vj == val && jj < j)) ? 1 : 0; }
        const u32 mask = (u32)(__ballot(rank < 8) & 0xffffffffull);
#pragma unroll
        for (int r = 0; r < 4; ++r) { const bf16_t* qp = prow + (g * 4 + r) * 64;
            { float lg[8]; u32 mm = mask; float mx = -1e30f;
#pragma unroll
              for (int n = 0; n < 8; ++n) { const int jb = __builtin_ctz(mm); mm &= mm - 1; const int kpos = jb * 64 + lane;
                  lg[n] = (kpos <= t) ? 0.125f * dot64(qp, ACT + (size_t)(b * SEQ + kpos) * N1 + C1_KS + g * 64) : -1e30f; mx = fmaxf(mx, lg[n]); }
              mx = wave_max(mx); float sm = 0.f;
#pragma unroll
              for (int n = 0; n < 8; ++n) { lg[n] = __expf(lg[n] - mx); sm += lg[n]; }
              sm = wave_sum(sm); mm = mask; float acc = 0.f;
#pragma unroll
              for (int n = 0; n < 8; ++n) { const int jb = __builtin_ctz(mm); mm &= mm - 1; const bf16_t* vb = ACT + (size_t)(b * SEQ + jb * 64) * N1 + C1_VS + g * 64 + lane;
                  for (int key = 0; key < 64; ++key) { const float pk = __shfl(lg[n], key); acc += pk * bf2f(vb[(size_t)key * N1]); } }
              os[r] = acc / sm; }
            { float lg[8]; float mx = -1e30f;
#pragma unroll
              for (int n = 0; n < 8; ++n) { const int kpos = t - 511 + 64 * n + lane;
                  lg[n] = (kpos >= 0) ? 0.125f * dot64(qp, ACT + (size_t)(b * SEQ + kpos) * N1 + C1_KW + g * 64) : -1e30f; mx = fmaxf(mx, lg[n]); }
              mx = wave_max(mx); float sm = 0.f;
#pragma unroll
              for (int n = 0; n < 8; ++n) { lg[n] = __expf(lg[n] - mx); sm += lg[n]; }
              sm = wave_sum(sm); float acc = 0.f;
#pragma unroll
              for (int n = 0; n < 8; ++n) { const int k0 = t - 511 + 64 * n;
                  for (int key = 0; key < 64; ++key) { const int kpos = k0 + key; const float pk = __shfl(lg[n], key); if (kpos >= 0) acc += pk * bf2f(ACT[(size_t)(b * SEQ + kpos) * N1 + C1_VW + g * 64 + lane]); } }
              ow[r] = acc / sm; } }
#pragma unroll
        for (int r = 0; r < 4; ++r) { const int h = g * 4 + r; const float gc = sigmoidf_(bf2f(prow[C1_GATE + h * 3])), gs = sigmoidf_(bf2f(prow[C1_GATE + h * 3 + 1])), gw = sigmoidf_(bf2f(prow[C1_GATE + h * 3 + 2]));
            const float z = bf2f(prow[C1_Z + h * 64 + lane]); const float o = gc * oc[r] + gs * os[r] + gw * ow[r];
            AO[(size_t)row * DM + h * 64 + lane] = f2bf(o * z * sigmoidf_(z)); }
      } }
    grid.sync();

    { APlain af{AO, DM};
      auto epi = [&](int row, int col0, const float (&acc)[16]) { float* orow = out + (size_t)row * DM + col0;
#pragma unroll
          for (int j = 0; j < 16; ++j) orow[j] = orow[j] + acc[j]; };
      gemm_simple(af, WO1T, DM, MTOK, DM, DM, ldsf, epi); }
    grid.sync();
    for (int row = gwave; row < MTOK; row += nwaves) { float* xr = out + (size_t)row * DM; float4 v[4]; float ss = 0.f;
#pragma unroll
        for (int j = 0; j < 4; ++j) { v[j] = *(const float4*)(xr + j * 256 + lane * 4); ss += v[j].x * v[j].x + v[j].y * v[j].y + v[j].z * v[j].z + v[j].w * v[j].w; }
        ss = wave_sum(ss); const float rstd = rsqrtf(ss * (1.f / DM) + EPS);
#pragma unroll
        for (int j = 0; j < 4; ++j) { const float4 gg = *(const float4*)(final_g + j * 256 + lane * 4); float4 o; o.x = v[j].x * rstd * gg.x; o.y = v[j].y * rstd * gg.y; o.z = v[j].z * rstd * gg.z; o.w = v[j].w * rstd * gg.w; *(float4*)(xr + j * 256 + lane * 4) = o; } }
}

extern "C" void kernel_launch(void* const* d_in, const int* in_sizes, int n_in, void* d_out, int out_size, void* d_ws, size_t ws_size, hipStream_t stream) {
    constexpr size_t kDynLds = 65536;
    static int grid_blocks = 0;
    if (!grid_blocks) {
        int dev = 0, cus = 0, per_cu = 0;
        hipGetDevice(&dev);
        hipDeviceGetAttribute(&cus, hipDeviceAttributeMultiprocessorCount, dev);
        hipFuncSetAttribute((const void*)fwd_kernel, hipFuncAttributeMaxDynamicSharedMemorySize, (int)kDynLds);
        hipOccupancyMaxActiveBlocksPerMultiprocessor(&per_cu, (const void*)fwd_kernel, 512, kDynLds);
        if (per_cu < 1) per_cu = 1;
        if (per_cu > 2) per_cu = 2;
        grid_blocks = cus * per_cu;
        if (n_in != 14 || ws_size < WS_END) fprintf(stderr, "kernel_launch: unexpected n_in %d / ws_size %zu\n", n_in, ws_size);
    }
    Params p{};
    for (int i = 0; i < 14; ++i) p.in[i] = (const float*)d_in[i];
    p.out = (float*)d_out; p.ws = (unsigned char*)d_ws;
    void* args[] = {&p};
    hipError_t e = hipLaunchCooperativeKernel((const void*)fwd_kernel, dim3(grid_blocks), dim3(512), args, kDynLds, stream);
    if (e != hipSuccess) fprintf(stderr, "cooperative launch failed: %s (grid %d)\n", hipGetErrorString(e), grid_blocks);
}
```

```cpp
#include <hip/hip_runtime.h>
#include <hip/hip_cooperative_groups.h>
#include <cstdio>
#include <cstdint>
namespace cg = cooperative_groups;

typedef unsigned short bf16_t;
typedef unsigned int u32;

constexpr int DM = 1024, BATCH = 8, SEQ = 2048, MTOK = BATCH * SEQ;
constexpr int NH = 16, HD = 64;
constexpr int FOX_IN = 4 * DM + NH;
constexpr int NSA_IN = 3632;
constexpr int N0 = 4096;
constexpr int N1 = 3840;
constexpr int C1_Q = 0, C1_KC = 1024, C1_VC = 1280, C1_KS = 1536, C1_VS = 1792, C1_KW = 2048, C1_VW = 2304, C1_Z = 2560, C1_GATE = 3584;
constexpr int NCMP = 127, NCMP_P = 128;
constexpr float EPS = 1e-6f;

constexpr size_t MiB = 1u << 20;
constexpr size_t WS_CTL = 0;
constexpr size_t WS_W0T = 1 * MiB;
constexpr size_t WS_WO0T = 9 * MiB;
constexpr size_t WS_W1T = 11 * MiB;
constexpr size_t WS_WO1T = 19 * MiB;
constexpr size_t WS_WCK1T = 21 * MiB;
constexpr size_t WS_WCV1T = 22 * MiB;
constexpr size_t WS_WCK2T = 23 * MiB;
constexpr size_t WS_WCV2T = 23 * MiB + 65536;
constexpr size_t WS_CBIAS = 23 * MiB + 131072;
constexpr size_t WS_ROPE = 23 * MiB + 196608;
constexpr size_t WS_RS0 = 24 * MiB;
constexpr size_t WS_RS1 = 24 * MiB + 65536;
constexpr size_t WS_LOGF = 25 * MiB;
constexpr size_t WS_CUM = 26 * MiB;
constexpr size_t WS_KC = 27 * MiB;
constexpr size_t WS_VC = 27 * MiB + 524288;
constexpr size_t WS_HID = 28 * MiB;
constexpr size_t WS_XB = 32 * MiB;
constexpr size_t WS_ACT = 64 * MiB;
constexpr size_t WS_AO = 192 * MiB;
constexpr size_t WS_END = 224 * MiB;

struct Params { const float* in[14]; float* out; unsigned char* ws; };

__device__ __forceinline__ float bf2f(bf16_t v) { return __uint_as_float((u32)v << 16); }
__device__ __forceinline__ bf16_t f2bf(float f) { u32 u = __float_as_uint(f); return (bf16_t)((u + 0x7fffu + ((u >> 16) & 1u)) >> 16); }
__device__ __forceinline__ float lo_f(u32 w) { return __uint_as_float(w << 16); }
__device__ __forceinline__ float hi_f(u32 w) { return __uint_as_float(w & 0xffff0000u); }
__device__ __forceinline__ float wave_sum(float v) {
#pragma unroll
    for (int o = 1; o < 64; o <<= 1) v += __shfl_xor(v, o);
    return v;
}
__device__ __forceinline__ float wave_max(float v) {
#pragma unroll
    for (int o = 1; o < 64; o <<= 1) v = fmaxf(v, __shfl_xor(v, o));
    return v;
}
__device__ __forceinline__ float sigmoidf_(float x) { return 1.f / (1.f + __expf(-x)); }
__device__ __forceinline__ float dot64(const bf16_t* qu, const bf16_t* kp) {
    float s = 0.f;
#pragma unroll
    for (int i = 0; i < 8; ++i) {
        const uint4 a = ((const uint4*)qu)[i], b = ((const uint4*)kp)[i];
        s += lo_f(a.x) * lo_f(b.x); s += hi_f(a.x) * hi_f(b.x);
        s += lo_f(a.y) * lo_f(b.y); s += hi_f(a.y) * hi_f(b.y);
        s += lo_f(a.z) * lo_f(b.z); s += hi_f(a.z) * hi_f(b.z);
        s += lo_f(a.w) * lo_f(b.w); s += hi_f(a.w) * hi_f(b.w);
    }
    return s;
}

namespace pg8 {
#define PG8_LAS __attribute__((address_space(3)))
typedef PG8_LAS unsigned char* PG8_LAS_T;
typedef unsigned short bf16_t;
typedef short bf16x8 __attribute__((ext_vector_type(8)));
typedef float f32x4 __attribute__((ext_vector_type(4)));
typedef unsigned u32x4 __attribute__((ext_vector_type(4)));
constexpr int BM = 256, BK = 64, HALF = 128, HTB = HALF * BK * 2  , STAGE_BYTES = 8 * HTB, NXCD = 8, WGM = 8;

__host__ __device__ __forceinline__ int lds_byte(int r, int c) { const int st = (r >> 4) * 2 + (c >> 5), rr = r & 15, cc = c & 31, ob = rr * 64 + cc * 2; return st * 1024 + (ob ^ (((ob >> 9) & 1) << 5)); }
__host__ __device__ __forceinline__ void stage_rc(int b, int& R, int& C) { const int st = b / 1024, sb = b % 1024, swz = sb ^ (((sb >> 9) & 1) << 5); R = (st >> 1) * 16 + swz / 64; C = (st & 1) * 32 + (swz % 64) / 2; }
__host__ __device__ __forceinline__ int perm32(int rho) { const int n = rho >> 4, i = rho & 15; return 8 * (i >> 2) + 4 * n + (i & 3); }

struct Unit { int pm, pn; };
struct Gemm { const bf16_t* A; const bf16_t* Bt; int M, N, K; };

struct StaticOrder {
    int nM, nN, nwg, G, c;
    __host__ __device__ void init(int M, int N, int G_, int c_) { nM = M / BM; nN = N / BM; nwg = nM * nN; G = G_; c = c_; }
    __host__ __device__ bool next(int i, Unit& u) const {
        const long L = (long)i * G + c; if (L >= nwg) return false;
        int wgid = (int)L; { const int q = nwg / NXCD, r = nwg % NXCD, xcd = wgid % NXCD, off = wgid / NXCD; wgid = (xcd < r ? xcd * (q + 1) : r * (q + 1) + (xcd - r) * q) + off; }
        const int nig = WGM * nN, gid = wgid / nig, fm = gid * WGM, gsz = (nM - fm) < WGM ? (nM - fm) : WGM;
        u.pm = fm + ((wgid % nig) % gsz); u.pn = (wgid % nig) / gsz; return true;
    }
    __device__ __forceinline__ void a_ready(const Unit&) const {}
    __device__ __forceinline__ void done(const Unit&) const {}
};

__device__ __forceinline__ unsigned cvt_pk_bf16(float lo, float hi) { unsigned r; asm volatile("v_cvt_pk_bf16_f32 %0, %1, %2" : "=v"(r) : "v"(lo), "v"(hi)); return r; }
typedef float f32x2 __attribute__((ext_vector_type(2)));
__device__ __forceinline__ f32x2 gelu_pk(f32x2 v) {
    const f32x2 av = __builtin_elementwise_abs(v), d = av * 0.2316418882f + 1.0f;
    f32x2 t; t.x = __builtin_amdgcn_rcpf(d.x); t.y = __builtin_amdgcn_rcpf(d.y);
    f32x2 q = t * 0.5307027145f + (-0.7265760135f); q = q * t + 0.7107068705f; q = q * t + (-0.142248368f); q = q * t + 0.127414796f; q = q * t;
    const f32x2 s = (v * v) * (-0.72134752044f);
    f32x2 e; e.x = __builtin_amdgcn_exp2f(s.x); e.y = __builtin_amdgcn_exp2f(s.y);
    const f32x2 m = v * (q * e), r = v - m;
    f32x2 o; o.x = v.x < 0.f ? m.x : r.x; o.y = v.y < 0.f ? m.y : r.y; return o;
}

template <int ACT  > struct EpiBf16 {
    static constexpr bool PERM = true, AFTER_DRAIN = false; static_assert(ACT == 0 || ACT == 1, "EpiBf16: ACT is 0 (none) or 1 (gelu_pk)");
    bf16_t* O; int ldc; const float* bias; int split_cols; size_t split_stride; float scale0;
    __device__ __forceinline__ void operator()(const f32x4 (&acc)[2][2][4][2], const Unit& u, int wr, int wc, int fr, int fq) const {
        const int row0 = u.pm * BM + wr * 64 + fr; int colt = u.pn * BM; bf16_t* base = O;
        float sc = 1.f; if (split_cols) { const int t = colt / split_cols; base += (size_t)t * split_stride; colt -= t * split_cols; if (t == 0) sc = scale0; }
        const int col0 = colt + wc * 32 + 8 * fq, bcol0 = u.pn * BM + wc * 32 + 8 * fq;
        f32x4 bv[2][2];
#pragma unroll
        for (int bj = 0; bj < 2; ++bj)
#pragma unroll
            for (int n = 0; n < 2; ++n) bv[bj][n] = bias ? *(const f32x4*)(bias + bcol0 + bj * HALF + 4 * n) : (f32x4){0.f, 0.f, 0.f, 0.f};
#pragma unroll
        for (int ai = 0; ai < 2; ++ai)
#pragma unroll
            for (int m = 0; m < 4; ++m) { bf16_t* rowp = base + (size_t)(row0 + ai * HALF + m * 16) * ldc + col0;
#pragma unroll
                for (int bj = 0; bj < 2; ++bj) { f32x4 v0 = acc[ai][bj][m][0] + bv[bj][0], v1 = acc[ai][bj][m][1] + bv[bj][1];
                    if (ACT == 1) { f32x2 a = gelu_pk((f32x2){v0[0], v0[1]}), b = gelu_pk((f32x2){v0[2], v0[3]}), c = gelu_pk((f32x2){v1[0], v1[1]}), d = gelu_pk((f32x2){v1[2], v1[3]});
                        v0 = (f32x4){a.x, a.y, b.x, b.y}; v1 = (f32x4){c.x, c.y, d.x, d.y}; }
                    v0 = v0 * sc; v1 = v1 * sc; u32x4 w; w.x = cvt_pk_bf16(v0[0], v0[1]); w.y = cvt_pk_bf16(v0[2], v0[3]); w.z = cvt_pk_bf16(v1[0], v1[1]); w.w = cvt_pk_bf16(v1[2], v1[3]);
                    *(u32x4*)(rowp + bj * HALF) = w; } }
    }
};

struct PanelStats {
    unsigned* xbuf;
    unsigned* cnt;
    unsigned* tmo;
    int ntn; float eps;
    unsigned code;
    __device__ __forceinline__ bool run(const f32x4 (&v)[2][2][4][2], const Unit& u, int wr, int wc, int fr, int fq, PG8_LAS unsigned char* lds, int wid, int lane) const {
        typedef float f32x2v __attribute__((ext_vector_type(2)));
        PG8_LAS f32x2v* P = (PG8_LAS f32x2v*)lds;
        PG8_LAS f32x2v* S = (PG8_LAS f32x2v*)(lds + 8192);
        PG8_LAS unsigned* flag = (PG8_LAS unsigned*)(lds + 8192 + 2048);
#pragma unroll
        for (int ai = 0; ai < 2; ++ai)
#pragma unroll
            for (int m = 0; m < 4; ++m) {
                float s = 0.f;
#pragma unroll
                for (int bj = 0; bj < 2; ++bj)
#pragma unroll
                    for (int n = 0; n < 2; ++n) { const f32x4 x = v[ai][bj][m][n]; s += (x[0] + x[1]) + (x[2] + x[3]); }
                s += __shfl_xor(s, 16); s += __shfl_xor(s, 32);
                const float mw = s * (1.0f / 64.0f); float q = 0.f;
#pragma unroll
                for (int bj = 0; bj < 2; ++bj)
#pragma unroll
                    for (int n = 0; n < 2; ++n) { const f32x4 d = v[ai][bj][m][n] - mw; q += (d[0] * d[0] + d[1] * d[1]) + (d[2] * d[2] + d[3] * d[3]); }
                q += __shfl_xor(q, 16); q += __shfl_xor(q, 32);
                if (fq == 0) P[(ai * HALF + wr * 64 + m * 16 + fr) * 4 + wc] = (f32x2v){mw, q};
            }
        asm volatile("s_waitcnt lgkmcnt(0)" ::: "memory"); __builtin_amdgcn_s_barrier(); asm volatile("" ::: "memory");
#if defined(BROKEN_EXCHANGE_NO_WAIT)
#warning BROKEN CONTROL BUILD: the row-statistics exchange does not wait; results are wrong by design
        if (blockIdx.x >= 64) { const long long t0_ = clock64(); while (clock64() - t0_ < 60000) __builtin_amdgcn_s_sleep(8); }
#endif
        const int row = wid * 32 + (lane & 31);
        if (lane < 32) {
            const f32x2v a = P[row * 4 + 0], b = P[row * 4 + 1], c = P[row * 4 + 2], d = P[row * 4 + 3];
            const float mt = (a.x + b.x + c.x + d.x) * 0.25f;
            const float da = a.x - mt, db = b.x - mt, dc = c.x - mt, dd = d.x - mt;
            const float m2 = (a.y + b.y) + (c.y + d.y) + 64.0f * ((da * da + db * db) + (dc * dc + dd * dd));
            unsigned long long* slot = (unsigned long long*)xbuf + ((size_t)(u.pm * BM + row) * 4 + u.pn);
            __hip_atomic_store(slot, ((unsigned long long)__float_as_uint(m2) << 32) | __float_as_uint(mt), __ATOMIC_RELAXED, __HIP_MEMORY_SCOPE_AGENT);
        }
        asm volatile("s_waitcnt vmcnt(0)" ::: "memory");
        if (lane == 0) __hip_atomic_fetch_add(cnt + 64 * u.pm, 1u, __ATOMIC_RELAXED, __HIP_MEMORY_SCOPE_AGENT);
        if (wid == 0) {
            bool dead = false; const unsigned long long t0 = __builtin_amdgcn_s_memrealtime(); const unsigned want = 8u * (unsigned)ntn;
            for (;;) {
#if defined(BROKEN_EXCHANGE_NO_WAIT)
                break;
#endif
                if ((unsigned)__builtin_amdgcn_readfirstlane(__hip_atomic_load(cnt + 64 * u.pm, __ATOMIC_RELAXED, __HIP_MEMORY_SCOPE_AGENT)) >= want) break;
                if (__builtin_amdgcn_s_memrealtime() - t0 > 2000000ull) {
                    if (lane == 0) { unsigned expect = 0u; __hip_atomic_compare_exchange_strong(tmo + 1, &expect, code | (unsigned)(u.pm & 0xff), __ATOMIC_RELAXED, __ATOMIC_RELAXED, __HIP_MEMORY_SCOPE_AGENT);
                                     __hip_atomic_store(tmo, 1u, __ATOMIC_RELAXED, __HIP_MEMORY_SCOPE_AGENT); }
                    dead = true; break; }
                __builtin_amdgcn_s_sleep(2);
            }
            __builtin_amdgcn_fence(__ATOMIC_ACQUIRE, "agent");
            if (lane == 0) flag[0] = dead ? 1u : 0u;
        }
        asm volatile("s_waitcnt vmcnt(0) lgkmcnt(0)" ::: "memory"); __builtin_amdgcn_s_barrier(); asm volatile("" ::: "memory");
        const bool bad = flag[0] != 0u;
        if (lane < 32) {
            const unsigned long long* slot = (const unsigned long long*)xbuf + (size_t)(u.pm * BM + row) * 4; float mt[4], m2[4]; float ms = 0.f;
#pragma unroll
            for (int t = 0; t < 4; ++t) { if (t < ntn) { const unsigned long long w = __hip_atomic_load(slot + t, __ATOMIC_RELAXED, __HIP_MEMORY_SCOPE_AGENT); mt[t] = __uint_as_float((unsigned)w); m2[t] = __uint_as_float((unsigned)(w >> 32)); } else { mt[t] = 0.f; m2[t] = 0.f; } ms += mt[t]; }
            const float mean = ms / (float)ntn; float q = 0.f;
#pragma unroll
            for (int t = 0; t < 4; ++t) if (t < ntn) { const float dm = mt[t] - mean; q += m2[t] + 256.0f * dm * dm; }
            S[row] = (f32x2v){mean, 1.0f / sqrtf(q / (256.0f * (float)ntn) + eps)};
        }
        asm volatile("s_waitcnt lgkmcnt(0)" ::: "memory"); __builtin_amdgcn_s_barrier(); asm volatile("" ::: "memory");
        return bad;
    }
};
struct EpiLnRes {
    static constexpr bool PERM = false, AFTER_DRAIN = true;
    const float* base; float* out; int ldc; const float* bias; PanelStats st; unsigned poison;
    __device__ __forceinline__ void fused(f32x4 (&acc)[2][2][4][2], const Unit& u, int wr, int wc, int fr, int fq, PG8_LAS unsigned char* lds, int wid, int lane) const {
        typedef float f32x2v __attribute__((ext_vector_type(2)));
        const PG8_LAS f32x2v* S = (const PG8_LAS f32x2v*)(lds + 8192);
        const int col0 = u.pn * BM + wc * 32 + 4 * fq;
#pragma unroll
        for (int bj = 0; bj < 2; ++bj)
#pragma unroll
            for (int n = 0; n < 2; ++n) { const f32x4 bv = bias ? *(const f32x4*)(bias + col0 + bj * HALF + n * 16) : (f32x4){0.f, 0.f, 0.f, 0.f};
#pragma unroll
                for (int ai = 0; ai < 2; ++ai)
#pragma unroll
                    for (int m = 0; m < 4; ++m) acc[ai][bj][m][n] += bv; }
        f32x4 pre[4][2][2];
#pragma unroll
        for (int m = 0; m < 4; ++m) { const size_t off = (size_t)(u.pm * BM + wr * 64 + m * 16 + fr) * ldc + col0;
#pragma unroll
            for (int bj = 0; bj < 2; ++bj)
#pragma unroll
                for (int n = 0; n < 2; ++n) pre[m][bj][n] = *(const f32x4*)(base + off + bj * HALF + n * 16); }
        const bool bad = st.run(acc, u, wr, wc, fr, fq, lds, wid, lane) || poison != 0u;
        const float qnan = __builtin_nanf("");
#pragma unroll
        for (int ai = 0; ai < 2; ++ai)
#pragma unroll
            for (int m = 0; m < 4; ++m) { const int r = ai * HALF + wr * 64 + m * 16 + fr; const f32x2v sr = S[r]; const size_t off = (size_t)(u.pm * BM + r) * ldc + col0;
#pragma unroll
                for (int bj = 0; bj < 2; ++bj)
#pragma unroll
                    for (int n = 0; n < 2; ++n) { const f32x4 bs = ai == 0 ? pre[m][bj][n] : *(const f32x4*)(base + off + bj * HALF + n * 16); f32x4 o = bs + (acc[ai][bj][m][n] - sr.x) * sr.y;
                        if (bad) o = (f32x4){qnan, qnan, qnan, qnan}; *(f32x4*)(out + off + bj * HALF + n * 16) = o; }
                if (m & 1) asm volatile("" ::: "memory"); }
    }
};
struct EpiLnResLn {
    static constexpr bool PERM = false, AFTER_DRAIN = true;
    const float* base; float* out; bf16_t* xn; int ldc; const float* bias; PanelStats st1, st2; unsigned poison;
    __device__ __forceinline__ void fused(f32x4 (&acc)[2][2][4][2], const Unit& u, int wr, int wc, int fr, int fq, PG8_LAS unsigned char* lds, int wid, int lane) const {
        typedef float f32x2v __attribute__((ext_vector_type(2))); typedef unsigned u32x2v __attribute__((ext_vector_type(2)));
        const PG8_LAS f32x2v* S = (const PG8_LAS f32x2v*)(lds + 8192);
        const int col0 = u.pn * BM + wc * 32 + 4 * fq;
#pragma unroll
        for (int bj = 0; bj < 2; ++bj)
#pragma unroll
            for (int n = 0; n < 2; ++n) { const f32x4 bv = bias ? *(const f32x4*)(bias + col0 + bj * HALF + n * 16) : (f32x4){0.f, 0.f, 0.f, 0.f};
#pragma unroll
                for (int ai = 0; ai < 2; ++ai)
#pragma unroll
                    for (int m = 0; m < 4; ++m) acc[ai][bj][m][n] += bv; }
        bool bad = st1.run(acc, u, wr, wc, fr, fq, lds, wid, lane) || poison != 0u;
        const float qnan = __builtin_nanf("");
#pragma unroll
        for (int ai = 0; ai < 2; ++ai)
#pragma unroll
            for (int m = 0; m < 4; ++m) { const int r = ai * HALF + wr * 64 + m * 16 + fr; const f32x2v sr = S[r]; const size_t off = (size_t)(u.pm * BM + r) * ldc + col0;
#pragma unroll
                for (int bj = 0; bj < 2; ++bj)
#pragma unroll
                    for (int n = 0; n < 2; ++n) { const f32x4 bs = *(const f32x4*)(base + off + bj * HALF + n * 16); acc[ai][bj][m][n] = bs + (acc[ai][bj][m][n] - sr.x) * sr.y; }
                asm volatile("" : "+v"(acc[ai][0][m][0]), "+v"(acc[ai][0][m][1]), "+v"(acc[ai][1][m][0]), "+v"(acc[ai][1][m][1]));
                if (m & 1) asm volatile("" ::: "memory"); }
        const bool bad1 = bad;
        bad = st2.run(acc, u, wr, wc, fr, fq, lds, wid, lane) || bad;
#pragma unroll
        for (int ai = 0; ai < 2; ++ai)
#pragma unroll
            for (int m = 0; m < 4; ++m) { const int r = ai * HALF + wr * 64 + m * 16 + fr; const f32x2v sr = S[r]; const size_t off = (size_t)(u.pm * BM + r) * ldc + col0;
#pragma unroll
                for (int bj = 0; bj < 2; ++bj)
#pragma unroll
                    for (int n = 0; n < 2; ++n) { const f32x4 x1 = acc[ai][bj][m][n]; *(f32x4*)(out + off + bj * HALF + n * 16) = bad1 ? (f32x4){qnan, qnan, qnan, qnan} : x1;
                        const f32x4 o = (x1 - sr.x) * sr.y; u32x2v w; w.x = cvt_pk_bf16(o[0], o[1]); w.y = cvt_pk_bf16(o[2], o[3]);
                        if (bad) { w.x = 0x7fc07fc0u; w.y = 0x7fc07fc0u; } *(u32x2v*)(xn + off + bj * HALF + n * 16) = w; }
                asm volatile("" ::: "memory"); }
    }
};

template <class Epi, class Sched, bool ALIGN_EPI = false, bool SP2 = false>
__device__ __forceinline__ void gemm_phase(PG8_LAS unsigned char* lds, const Gemm g, const Sched& S, const Epi& E) {
    const int tid = threadIdx.x, wid = __builtin_amdgcn_readfirstlane(tid >> 6), lane = tid & 63, wr = wid >> 2, wc = wid & 3, fr = lane & 15, fq = lane >> 4;
    const int K = g.K, nt = K / BK;
    unsigned voffA[2], voffB[2];
#pragma unroll
    for (int i = 0; i < 2; ++i) { int R, C; stage_rc(tid * 16 + i * 8192, R, C); const int Rb = Epi::PERM ? ((R & ~31) + perm32(R & 31)) : R;
        voffA[i] = (unsigned)(R * K + C) * 2u; voffB[i] = (unsigned)(Rb * K + C) * 2u; }
    const size_t kstep = (size_t)(BK * 2);
    const size_t hstep = (size_t)HALF * K * 2;
    const size_t tstep = 2 * hstep;
    const unsigned ldsw = (unsigned)wid * 1024u;
    const int aoff = lds_byte(wr * 64 + fr, fq * 8), boff = lds_byte(wc * 32 + fr, fq * 8);
#define PG8_SA(b, h) (((b) * 2 + (h)) * HTB)
#define PG8_SB(b, h) ((4 + (b) * 2 + (h)) * HTB)
#define PG8_STAGE(bufoff, gbase, voff) do { _Pragma("unroll") for (int _i = 0; _i < 2; ++_i) \
        __builtin_amdgcn_global_load_lds((const unsigned*)((const char*)(gbase) + (voff)[_i]), (PG8_LAS unsigned*)(lds + (bufoff) + ldsw + _i * 8192), 16, 0, 0); } while (0)
#define PG8_LDA(dst, b, h) do { _Pragma("unroll") for (int m = 0; m < 4; ++m) _Pragma("unroll") for (int k = 0; k < 2; ++k) dst[m][k] = *(const PG8_LAS bf16x8*)(lds + PG8_SA(b, h) + aoff + m * 2048 + k * 1024); } while (0)
#define PG8_LDB(dst, b, h) do { _Pragma("unroll") for (int n = 0; n < 2; ++n) _Pragma("unroll") for (int k = 0; k < 2; ++k) dst[n][k] = *(const PG8_LAS bf16x8*)(lds + PG8_SB(b, h) + boff + n * 2048 + k * 1024); } while (0)
#define PG8_MMA(ai, bj, At, Bt) do { __builtin_amdgcn_s_setprio(1); _Pragma("unroll") for (int m = 0; m < 4; ++m) _Pragma("unroll") for (int n = 0; n < 2; ++n) _Pragma("unroll") for (int k = 0; k < 2; ++k) \
        acc[ai][bj][m][n] = __builtin_amdgcn_mfma_f32_16x16x32_bf16(Bt[n][k], At[m][k], acc[ai][bj][m][n], 0, 0, 0); __builtin_amdgcn_s_setprio(0); } while (0)
#define PG8_WAIT_V(n) asm volatile("s_waitcnt vmcnt(" #n ")" ::: "memory")
#define PG8_WAIT_L(n) asm volatile("s_waitcnt lgkmcnt(" #n ")" ::: "memory")
#define PG8_BAR __builtin_amdgcn_s_barrier()
#define PG8_SCHED __builtin_amdgcn_sched_barrier(0)
    Unit cur, nxt; int ui = 0;
    if (!S.next(0, cur)) return;
    f32x4 acc[2][2][4][2];
#pragma unroll
    for (int a = 0; a < 2; ++a)
#pragma unroll
        for (int b = 0; b < 2; ++b)
#pragma unroll
            for (int m = 0; m < 4; ++m)
#pragma unroll
                for (int n = 0; n < 2; ++n) acc[a][b][m][n] = (f32x4){0.f, 0.f, 0.f, 0.f};
    bf16x8 At[4][2], B0[2][2], B1[2][2];
    const char* cA = (const char*)g.A + (size_t)cur.pm * tstep; const char* cB = (const char*)g.Bt + (size_t)cur.pn * tstep;
    S.a_ready(cur);
    if constexpr (SP2) {
        PG8_STAGE(PG8_SB(0, 0), cB, voffB); PG8_STAGE(PG8_SB(0, 1), cB + hstep, voffB); PG8_STAGE(PG8_SA(0, 0), cA, voffA); PG8_STAGE(PG8_SA(0, 1), cA + hstep, voffA);
        if (wr == 1) PG8_BAR;
        PG8_WAIT_V(2); PG8_BAR;
        PG8_STAGE(PG8_SB(1, 0), cB + kstep, voffB); PG8_STAGE(PG8_SA(1, 0), cA + kstep, voffA); PG8_STAGE(PG8_SB(1, 1), cB + hstep + kstep, voffB);
        PG8_WAIT_V(6); PG8_BAR;
    } else {
        PG8_STAGE(PG8_SB(0, 0), cB, voffB); PG8_STAGE(PG8_SA(0, 0), cA, voffA); PG8_STAGE(PG8_SB(0, 1), cB + hstep, voffB); PG8_STAGE(PG8_SA(0, 1), cA + hstep, voffA);
        if (wr == 1) PG8_BAR;
        PG8_WAIT_V(4); PG8_BAR;
        PG8_STAGE(PG8_SB(1, 0), cB + kstep, voffB); PG8_STAGE(PG8_SA(1, 0), cA + kstep, voffA); PG8_STAGE(PG8_SB(1, 1), cB + hstep + kstep, voffB);
        PG8_WAIT_V(6); PG8_BAR;
    }
    for (;;) {
        const bool has_next = S.next(ui + 1, nxt);
        const char* nA = has_next ? (const char*)g.A + (size_t)nxt.pm * tstep : cA; const char* nB = has_next ? (const char*)g.Bt + (size_t)nxt.pn * tstep : cB;
        for (int t = 0; t < nt; t += 2) {
            const bool last = (t == nt - 2);
            const char* a1 = cA + (size_t)(t + 1) * kstep;
            const char* a2 = last ? nA : cA + (size_t)(t + 2) * kstep; const char* b2 = last ? nB : cB + (size_t)(t + 2) * kstep;
            const char* a3 = a2 + kstep; const char* b3 = b2 + kstep;
            if (last && has_next) S.a_ready(nxt);
            if constexpr (SP2) {
            PG8_LDB(B0, 0, 0); PG8_LDB(B1, 0, 1); PG8_SCHED; PG8_LDA(At, 0, 0); PG8_STAGE(PG8_SA(1, 1), a1 + hstep, voffA);
            PG8_WAIT_V(8); PG8_WAIT_L(0); PG8_BAR; PG8_MMA(0, 0, At, B0); PG8_MMA(0, 1, At, B1); PG8_BAR; PG8_SCHED;
            PG8_LDA(At, 0, 1); PG8_STAGE(PG8_SB(0, 0), b2, voffB); PG8_STAGE(PG8_SB(0, 1), b2 + hstep, voffB); PG8_STAGE(PG8_SA(0, 0), a2, voffA);
            PG8_WAIT_V(8); PG8_WAIT_L(0); PG8_BAR; PG8_MMA(1, 0, At, B0); PG8_MMA(1, 1, At, B1); PG8_BAR; PG8_SCHED;
            PG8_LDB(B0, 1, 0); PG8_LDB(B1, 1, 1); PG8_SCHED; PG8_LDA(At, 1, 0); PG8_STAGE(PG8_SA(0, 1), a2 + hstep, voffA);
            PG8_WAIT_V(8); PG8_WAIT_L(0); PG8_BAR; PG8_MMA(0, 0, At, B0); PG8_MMA(0, 1, At, B1); PG8_BAR; PG8_SCHED;
            PG8_LDA(At, 1, 1); PG8_STAGE(PG8_SB(1, 0), b3, voffB); PG8_STAGE(PG8_SB(1, 1), b3 + hstep, voffB); PG8_STAGE(PG8_SA(1, 0), a3, voffA);
            PG8_WAIT_V(8); PG8_WAIT_L(0); PG8_BAR; PG8_MMA(1, 0, At, B0); PG8_MMA(1, 1, At, B1); PG8_BAR; PG8_SCHED;
            } else {
            PG8_LDB(B0, 0, 0); PG8_SCHED; PG8_LDA(At, 0, 0); PG8_STAGE(PG8_SA(1, 1), a1 + hstep, voffA);
            PG8_WAIT_L(8); PG8_BAR; PG8_WAIT_L(0); PG8_MMA(0, 0, At, B0); PG8_BAR; PG8_SCHED;
            PG8_LDB(B1, 0, 1); PG8_STAGE(PG8_SB(0, 0), b2, voffB);
            PG8_BAR; PG8_WAIT_L(0); PG8_MMA(0, 1, At, B1); PG8_BAR;
            PG8_LDA(At, 0, 1); PG8_STAGE(PG8_SA(0, 0), a2, voffA);
            PG8_BAR; PG8_WAIT_L(0); PG8_MMA(1, 0, At, B0); PG8_BAR; PG8_SCHED;
            PG8_STAGE(PG8_SB(0, 1), b2 + hstep, voffB);
            PG8_WAIT_V(6); PG8_BAR; PG8_MMA(1, 1, At, B1); PG8_BAR;
            PG8_LDB(B0, 1, 0); PG8_SCHED; PG8_LDA(At, 1, 0); PG8_STAGE(PG8_SA(0, 1), a2 + hstep, voffA);
            PG8_WAIT_L(8); PG8_BAR; PG8_WAIT_L(0); PG8_MMA(0, 0, At, B0); PG8_BAR; PG8_SCHED;
            PG8_LDB(B1, 1, 1); PG8_STAGE(PG8_SB(1, 0), b3, voffB);
            PG8_BAR; PG8_WAIT_L(0); PG8_MMA(0, 1, At, B1); PG8_BAR;
            PG8_LDA(At, 1, 1); PG8_STAGE(PG8_SA(1, 0), a3, voffA);
            PG8_BAR; PG8_WAIT_L(0); PG8_MMA(1, 0, At, B0); PG8_BAR; PG8_SCHED;
            PG8_STAGE(PG8_SB(1, 1), b3 + hstep, voffB);
            PG8_WAIT_V(6); PG8_BAR; PG8_MMA(1, 1, At, B1); PG8_BAR;
            }
        }
        if constexpr (ALIGN_EPI) { if (wr == 0) PG8_BAR; }
        if constexpr (!Epi::AFTER_DRAIN) { E(acc, cur, wr, wc, fr, fq); S.done(cur); }
        if (!has_next) break;
#pragma unroll
        for (int a = 0; a < 2; ++a)
#pragma unroll
            for (int b = 0; b < 2; ++b)
#pragma unroll
                for (int m = 0; m < 4; ++m)
#pragma unroll
                    for (int n = 0; n < 2; ++n) acc[a][b][m][n] = (f32x4){0.f, 0.f, 0.f, 0.f};
        cur = nxt; cA = nA; cB = nB; ++ui;
        if constexpr (ALIGN_EPI) { if (wr == 1) PG8_BAR; }
    }
    PG8_WAIT_V(0);
    if constexpr (!ALIGN_EPI) { if (wr == 0) PG8_BAR; }
    PG8_BAR;
    if constexpr (Epi::AFTER_DRAIN) { E.fused(acc, cur, wr, wc, fr, fq, lds, wid, lane); S.done(cur); }
#undef PG8_SA
#undef PG8_SB
#undef PG8_STAGE
#undef PG8_LDA
#undef PG8_LDB
#undef PG8_MMA
#undef PG8_WAIT_V
#undef PG8_WAIT_L
#undef PG8_BAR
#undef PG8_SCHED
}
}


namespace pg8 {
struct EpiProj {
    static constexpr bool PERM = true, AFTER_DRAIN = false;
    bf16_t* O; int ldc; const float* rs; const float* rope; unsigned rope_mask;
    __device__ __forceinline__ void operator()(const f32x4 (&acc)[2][2][4][2], const Unit& u, int wr, int wc, int fr, int fq) const {
        const int row0 = u.pm * BM + wr * 64 + fr; const int col0 = u.pn * BM + wc * 32 + 8 * fq;
        const bool roped = ((rope_mask >> u.pn) & 1u) && ((wc & 1) == 0);
#pragma unroll
        for (int ai = 0; ai < 2; ++ai)
#pragma unroll
            for (int m = 0; m < 4; ++m) { const int row = row0 + ai * HALF + m * 16; const float s = rs[row]; bf16_t* rowp = O + (size_t)row * ldc + col0;
                f32x4 cs0 = {1.f, 1.f, 1.f, 1.f}, cs1 = cs0, sn0 = {0.f, 0.f, 0.f, 0.f}, sn1 = sn0;
                if (roped) { const float* rp = rope + (row & 2047) * 16; cs0 = *(const f32x4*)(rp); cs1 = *(const f32x4*)(rp + 4); sn0 = *(const f32x4*)(rp + 8); sn1 = *(const f32x4*)(rp + 12);
                    if (fq == 0) { sn0 = -sn0; sn1 = -sn1; } if (fq >= 2) { cs0 = (f32x4){1.f, 1.f, 1.f, 1.f}; cs1 = cs0; sn0 = (f32x4){0.f, 0.f, 0.f, 0.f}; sn1 = sn0; } }
#pragma unroll
                for (int bj = 0; bj < 2; ++bj) { f32x4 v0 = acc[ai][bj][m][0] * s, v1 = acc[ai][bj][m][1] * s;
                    if (roped) { f32x4 o0, o1;
#pragma unroll
                        for (int e = 0; e < 4; ++e) { o0[e] = __shfl_xor(v0[e], 16); o1[e] = __shfl_xor(v1[e], 16); }
                        v0 = v0 * cs0 + o0 * sn0; v1 = v1 * cs1 + o1 * sn1; }
                    u32x4 w; w.x = cvt_pk_bf16(v0[0], v0[1]); w.y = cvt_pk_bf16(v0[2], v0[3]); w.z = cvt_pk_bf16(v1[0], v1[1]); w.w = cvt_pk_bf16(v1[2], v1[3]);
                    *(u32x4*)(rowp + bj * HALF) = w; } }
    }
};
struct EpiResid {
    static constexpr bool PERM = true, AFTER_DRAIN = false;
    const float* base; float* out; bf16_t* ob; int ldc;
    __device__ __forceinline__ void operator()(const f32x4 (&acc)[2][2][4][2], const Unit& u, int wr, int wc, int fr, int fq) const {
        const int row0 = u.pm * BM + wr * 64 + fr; const int col0 = u.pn * BM + wc * 32 + 8 * fq;
#pragma unroll
        for (int ai = 0; ai < 2; ++ai)
#pragma unroll
            for (int m = 0; m < 4; ++m) { const size_t off = (size_t)(row0 + ai * HALF + m * 16) * ldc + col0;
#pragma unroll
                for (int bj = 0; bj < 2; ++bj) { const f32x4 b0 = *(const f32x4*)(base + off + bj * HALF), b1 = *(const f32x4*)(base + off + bj * HALF + 4);
                    const f32x4 v0 = b0 + acc[ai][bj][m][0], v1 = b1 + acc[ai][bj][m][1];
                    *(f32x4*)(out + off + bj * HALF) = v0; *(f32x4*)(out + off + bj * HALF + 4) = v1;
                    if (ob) { u32x4 w; w.x = cvt_pk_bf16(v0[0], v0[1]); w.y = cvt_pk_bf16(v0[2], v0[3]); w.z = cvt_pk_bf16(v1[0], v1[1]); w.w = cvt_pk_bf16(v1[2], v1[3]); *(u32x4*)(ob + off + bj * HALF) = w; } } }
    }
};
}

struct APlain { const bf16_t* A; int lda; __device__ __forceinline__ const bf16_t* operator()(int m, int k) const { return A + (size_t)m * lda + k; } };
struct ACmp { const bf16_t* act; int col0; __device__ __forceinline__ const bf16_t* operator()(int m, int k) const {
    const int g = m & 3, c0 = (m >> 2) & 127, b = m >> 9; const int c = c0 > 126 ? 126 : c0; const int l = k >> 6, d = k & 63;
    return act + (size_t)(b * SEQ + 16 * c + l) * N1 + col0 + g * 64 + d; } };

template <class AF, class Epi>
__device__ __forceinline__ void gemm_simple(const AF& af, const bf16_t* Bt, int ldb, int M, int N, int K, float* lds, const Epi& epi) {
    float* As = lds;
    float* Bs = lds + 128 * 33;
    const int tid = threadIdx.x, r = tid & 127, cgp = tid >> 7;
    const int tilesN = N / 64, ntiles = (M / 128) * tilesN;
    for (int tile = blockIdx.x; tile < ntiles; tile += gridDim.x) {
        const int tm = tile / tilesN, tn = tile % tilesN;
        float acc[16];
#pragma unroll
        for (int j = 0; j < 16; ++j) acc[j] = 0.f;
        for (int k0 = 0; k0 < K; k0 += 32) {
            __syncthreads();
            { const int ar = tid >> 2, ak = (tid & 3) * 8; const uint4 v = *(const uint4*)af(tm * 128 + ar, k0 + ak); float* d = As + ar * 33 + ak;
              d[0] = lo_f(v.x); d[1] = hi_f(v.x); d[2] = lo_f(v.y); d[3] = hi_f(v.y); d[4] = lo_f(v.z); d[5] = hi_f(v.z); d[6] = lo_f(v.w); d[7] = hi_f(v.w); }
            if (tid < 256) { const int bn = tid >> 2, bk = (tid & 3) * 8; const uint4 v = *(const uint4*)(Bt + (size_t)(tn * 64 + bn) * ldb + k0 + bk); float* d = Bs + bk * 64 + bn;
              d[0] = lo_f(v.x); d[64] = hi_f(v.x); d[128] = lo_f(v.y); d[192] = hi_f(v.y); d[256] = lo_f(v.z); d[320] = hi_f(v.z); d[384] = lo_f(v.w); d[448] = hi_f(v.w); }
            __syncthreads();
#pragma unroll 4
            for (int kk = 0; kk < 32; ++kk) {
                const float a = As[r * 33 + kk]; const float* bp = Bs + kk * 64 + cgp * 16;
#pragma unroll
                for (int j = 0; j < 16; ++j) acc[j] += a * bp[j];
            }
        }
        epi(tm * 128 + r, tn * 64 + cgp * 16, acc);
    }
}

__global__ void __launch_bounds__(512) fwd_kernel(Params p) {
    extern __shared__ __attribute__((aligned(16))) unsigned char lds_raw[];
    float* ldsf = (float*)lds_raw; pg8::PG8_LAS_T ldsL = (pg8::PG8_LAS_T)lds_raw;
    cg::grid_group grid = cg::this_grid();
    const int tid = threadIdx.x, lane = tid & 63, wib = tid >> 6;
    const int gtid = blockIdx.x * 512 + tid, gsz = gridDim.x * 512;
    const int gwave = blockIdx.x * 8 + wib, nwaves = gridDim.x * 8;

    const float* x = p.in[0]; const float* norm_g = p.in[1]; const float* fox_w_in = p.in[2]; const float* fox_b_f = p.in[3]; const float* fox_w_out = p.in[4];
    const float* nsa_w_in = p.in[5]; const float* pe_k = p.in[6]; const float* w_ck1 = p.in[7]; const float* w_ck2 = p.in[8];
    const float* pe_v = p.in[9]; const float* w_cv1 = p.in[10]; const float* w_cv2 = p.in[11]; const float* nsa_w_out = p.in[12]; const float* final_g = p.in[13];
    float* out = p.out; unsigned char* ws = p.ws;
    bf16_t* W0T = (bf16_t*)(ws + WS_W0T); bf16_t* WO0T = (bf16_t*)(ws + WS_WO0T); bf16_t* W1T = (bf16_t*)(ws + WS_W1T); bf16_t* WO1T = (bf16_t*)(ws + WS_WO1T);
    bf16_t* WCK1T = (bf16_t*)(ws + WS_WCK1T); bf16_t* WCV1T = (bf16_t*)(ws + WS_WCV1T); bf16_t* WCK2T = (bf16_t*)(ws + WS_WCK2T); bf16_t* WCV2T = (bf16_t*)(ws + WS_WCV2T);
    float* CBIAS = (float*)(ws + WS_CBIAS); float* ROPE = (float*)(ws + WS_ROPE); float* RS0 = (float*)(ws + WS_RS0); float* RS1 = (float*)(ws + WS_RS1);
    float* LOGF = (float*)(ws + WS_LOGF); float* CUM = (float*)(ws + WS_CUM);
    bf16_t* KC = (bf16_t*)(ws + WS_KC); bf16_t* VC = (bf16_t*)(ws + WS_VC); bf16_t* HID = (bf16_t*)(ws + WS_HID);
    bf16_t* XB = (bf16_t*)(ws + WS_XB); bf16_t* ACT = (bf16_t*)(ws + WS_ACT); bf16_t* AO = (bf16_t*)(ws + WS_AO);
    const float* g0 = norm_g; const float* g1 = norm_g + DM;

    for (int i = gtid; i < N0 * DM; i += gsz) { const int k = i / N0, n = i % N0; const int col = n < 3072 ? n : n + 16; W0T[(size_t)n * DM + k] = f2bf(g0[k] * fox_w_in[(size_t)k * FOX_IN + col]); }
    for (int i = gtid; i < N1 * DM; i += gsz) { const int k = i / N1, n = i % N1; float v = 0.f;
        if (n < C1_Z) v = nsa_w_in[(size_t)k * NSA_IN + n]; else if (n < C1_GATE) v = nsa_w_in[(size_t)k * NSA_IN + n + 48]; else if (n < C1_GATE + 48) v = nsa_w_in[(size_t)k * NSA_IN + n - 1024];
        W1T[(size_t)n * DM + k] = f2bf(g1[k] * v); }
    for (int i = gtid; i < DM * DM; i += gsz) { const int k = i / DM, n = i % DM; WO0T[(size_t)n * DM + k] = f2bf(fox_w_out[i]); WO1T[(size_t)n * DM + k] = f2bf(nsa_w_out[i]); }
    for (int i = gtid; i < 2048 * 256; i += gsz) { const int k = i / 256, n = i % 256; WCK1T[(size_t)n * 2048 + k] = f2bf(w_ck1[i]); WCV1T[(size_t)n * 2048 + k] = f2bf(w_cv1[i]); }
    for (int i = gtid; i < 256 * 64; i += gsz) { const int k = i / 64, n = i % 64; WCK2T[n * 256 + k] = f2bf(w_ck2[i]); WCV2T[n * 256 + k] = f2bf(w_cv2[i]); }
    for (int i = gtid; i < SEQ * 8; i += gsz) { const int pos = i >> 3, j = i & 7; const double inv = pow(500000.0, -(double)j / 8.0); const double a = (double)pos * inv;
        ROPE[pos * 16 + j] = (float)cos(a); ROPE[pos * 16 + 8 + j] = (float)sin(a); }
    for (int o = gwave; o < 512; o += nwaves) { const int kv = o >> 8, n = o & 255; const float* pe = kv ? pe_v : pe_k; const float* w1 = kv ? w_cv1 : w_ck1; float s = 0.f;
        for (int k = lane; k < 2048; k += 64) s += pe[k] * w1[(size_t)k * 256 + n];
        s = wave_sum(s); if (lane == 0) CBIAS[o] = s; }
    for (int row = gwave; row < MTOK; row += nwaves) {
        const float* xr = x + (size_t)row * DM; float4 v[4]; float ss = 0.f;
#pragma unroll
        for (int j = 0; j < 4; ++j) { v[j] = *(const float4*)(xr + j * 256 + lane * 4); ss += v[j].x * v[j].x + v[j].y * v[j].y + v[j].z * v[j].z + v[j].w * v[j].w; }
        ss = wave_sum(ss); const float rstd = rsqrtf(ss * (1.f / DM) + EPS);
        if (lane == 0) RS0[row] = rstd;
#pragma unroll
        for (int j = 0; j < 4; ++j) { uint2 w; w.x = (u32)f2bf(v[j].x) | ((u32)f2bf(v[j].y) << 16); w.y = (u32)f2bf(v[j].z) | ((u32)f2bf(v[j].w) << 16); *(uint2*)(XB + (size_t)row * DM + j * 256 + lane * 4) = w; }
        for (int h = 0; h < NH; ++h) { float s = 0.f;
#pragma unroll
            for (int j = 0; j < 4; ++j) { const int k = j * 256 + lane * 4; const float4 gg = *(const float4*)(g0 + k);
                s += v[j].x * gg.x * fox_w_in[(size_t)(k + 0) * FOX_IN + 3072 + h]; s += v[j].y * gg.y * fox_w_in[(size_t)(k + 1) * FOX_IN + 3072 + h];
                s += v[j].z * gg.z * fox_w_in[(size_t)(k + 2) * FOX_IN + 3072 + h]; s += v[j].w * gg.w * fox_w_in[(size_t)(k + 3) * FOX_IN + 3072 + h]; }
            s = wave_sum(s); const float f = s * rstd + fox_b_f[h];
            if (lane == 0) LOGF[row * 16 + h] = fminf(f, 0.f) - log1pf(expf(-fabsf(f))); }
    }
    grid.sync();

    { pg8::Gemm g{XB, W0T, MTOK, N0, DM}; pg8::StaticOrder S; S.init(MTOK, N0, (int)gridDim.x, (int)blockIdx.x);
      pg8::EpiProj E{ACT, N0, RS0, ROPE, 0u};
      pg8::gemm_phase<pg8::EpiProj, pg8::StaticOrder, true, true>(ldsL, g, S, E); }
    for (int bh = gwave; bh < BATCH * NH; bh += nwaves) { const int b = bh >> 4, h = bh & 15; float loc = 0.f;
        for (int i = 0; i < 32; ++i) loc += LOGF[(size_t)(b * SEQ + lane * 32 + i) * 16 + h];
        float inc = loc;
#pragma unroll
        for (int o = 1; o < 64; o <<= 1) { const float t = __shfl_up(inc, o); if (lane >= o) inc += t; }
        float run = inc - loc;
        for (int i = 0; i < 32; ++i) { run += LOGF[(size_t)(b * SEQ + lane * 32 + i) * 16 + h]; CUM[(size_t)bh * SEQ + lane * 32 + i] = run; } }
    grid.sync();

    for (int task = gwave; task < BATCH * NH * (SEQ / 64); task += nwaves) {
        const int bh = task >> 5, tb = task & 31, b = bh >> 4, h = bh & 15, t = tb * 64 + lane; const size_t row = (size_t)b * SEQ + t;
        float q[64], o[64];
        { const uint4* qp = (const uint4*)(ACT + row * N0 + h * 64);
#pragma unroll
          for (int i = 0; i < 8; ++i) { const uint4 a = qp[i]; q[8 * i] = lo_f(a.x); q[8 * i + 1] = hi_f(a.x); q[8 * i + 2] = lo_f(a.y); q[8 * i + 3] = hi_f(a.y); q[8 * i + 4] = lo_f(a.z); q[8 * i + 5] = hi_f(a.z); q[8 * i + 6] = lo_f(a.w); q[8 * i + 7] = hi_f(a.w); } }
#pragma unroll
        for (int d = 0; d < 64; ++d) o[d] = 0.f;
        const float ct = CUM[(size_t)bh * SEQ + t]; float m = -1e30f, l = 0.f; const int smax = tb * 64 + 63;
        for (int s = 0; s <= smax; ++s) {
            const bf16_t* kr = ACT + ((size_t)b * SEQ + s) * N0 + 1024 + h * 64; const bf16_t* vr = kr + 1024; float dot = 0.f;
#pragma unroll
            for (int i = 0; i < 8; ++i) { const uint4 a = ((const uint4*)kr)[i];
                dot += q[8 * i] * lo_f(a.x) + q[8 * i + 1] * hi_f(a.x) + q[8 * i + 2] * lo_f(a.y) + q[8 * i + 3] * hi_f(a.y) + q[8 * i + 4] * lo_f(a.z) + q[8 * i + 5] * hi_f(a.z) + q[8 * i + 6] * lo_f(a.w) + q[8 * i + 7] * hi_f(a.w); }
            const float lg = dot * 0.125f + ct - CUM[(size_t)bh * SEQ + s];
            if (s <= t) { const float mn = fmaxf(m, lg), al = __expf(m - mn), pp = __expf(lg - mn); l = l * al + pp; m = mn;
#pragma unroll
                for (int i = 0; i < 8; ++i) { const uint4 a = ((const uint4*)vr)[i];
                    o[8 * i] = o[8 * i] * al + pp * lo_f(a.x); o[8 * i + 1] = o[8 * i + 1] * al + pp * hi_f(a.x); o[8 * i + 2] = o[8 * i + 2] * al + pp * lo_f(a.y); o[8 * i + 3] = o[8 * i + 3] * al + pp * hi_f(a.y);
                    o[8 * i + 4] = o[8 * i + 4] * al + pp * lo_f(a.z); o[8 * i + 5] = o[8 * i + 5] * al + pp * hi_f(a.z); o[8 * i + 6] = o[8 * i + 6] * al + pp * lo_f(a.w); o[8 * i + 7] = o[8 * i + 7] * al + pp * hi_f(a.w); } }
        }
        const float il = 1.f / l; const uint4* zp = (const uint4*)(ACT + row * N0 + 3072 + h * 64); uint4* op = (uint4*)(AO + row * DM + h * 64);
#pragma unroll
        for (int i = 0; i < 8; ++i) { const uint4 a = zp[i]; float z[8] = {lo_f(a.x), hi_f(a.x), lo_f(a.y), hi_f(a.y), lo_f(a.z), hi_f(a.z), lo_f(a.w), hi_f(a.w)}; u32 w[4];
#pragma unroll
            for (int e = 0; e < 4; ++e) { const float a0 = o[8 * i + 2 * e] * il * z[2 * e] * sigmoidf_(z[2 * e]), a1 = o[8 * i + 2 * e + 1] * il * z[2 * e + 1] * sigmoidf_(z[2 * e + 1]); w[e] = (u32)f2bf(a0) | ((u32)f2bf(a1) << 16); }
            op[i] = make_uint4(w[0], w[1], w[2], w[3]); }
    }
    grid.sync();

    { pg8::Gemm g{AO, WO0T, MTOK, DM, DM}; pg8::StaticOrder S; S.init(MTOK, DM, (int)gridDim.x, (int)blockIdx.x);
      pg8::EpiResid E{x, out, XB, DM};
      pg8::gemm_phase<pg8::EpiResid, pg8::StaticOrder, true, true>(ldsL, g, S, E); }
    grid.sync();
    for (int row = gwave; row < MTOK; row += nwaves) { const float* xr = out + (size_t)row * DM; float ss = 0.f;
#pragma unroll
        for (int j = 0; j < 4; ++j) { const float4 v = *(const float4*)(xr + j * 256 + lane * 4); ss += v.x * v.x + v.y * v.y + v.z * v.z + v.w * v.w; }
        ss = wave_sum(ss); if (lane == 0) RS1[row] = rsqrtf(ss * (1.f / DM) + EPS); }
    grid.sync();

    { pg8::Gemm g{XB, W1T, MTOK, N1, DM}; pg8::StaticOrder S; S.init(MTOK, N1, (int)gridDim.x, (int)blockIdx.x);
      pg8::EpiProj E{ACT, N1, RS1, ROPE, 0x14Fu};
      pg8::gemm_phase<pg8::EpiProj, pg8::StaticOrder, true, true>(ldsL, g, S, E); }
    grid.sync();

    for (int kv = 0; kv < 2; ++kv) { ACmp af{ACT, kv ? C1_VC : C1_KC}; const float* cb = CBIAS + kv * 256; bf16_t* hid = HID + (size_t)kv * 4096 * 256;
      auto epi = [&](int row, int col0, const float (&acc)[16]) { u32 w[8];
#pragma unroll
          for (int j = 0; j < 8; ++j) { const float a0 = acc[2 * j] + cb[col0 + 2 * j], a1 = acc[2 * j + 1] + cb[col0 + 2 * j + 1]; w[j] = (u32)f2bf(a0 * sigmoidf_(a0)) | ((u32)f2bf(a1 * sigmoidf_(a1)) << 16); }
          uint4* d = (uint4*)(hid + (size_t)row * 256 + col0); d[0] = make_uint4(w[0], w[1], w[2], w[3]); d[1] = make_uint4(w[4], w[5], w[6], w[7]); };
      gemm_simple(af, kv ? WCV1T : WCK1T, 2048, 4096, 256, 2048, ldsf, epi); }
    grid.sync();
    for (int kv = 0; kv < 2; ++kv) { APlain af{HID + (size_t)kv * 4096 * 256, 256}; bf16_t* dst = kv ? VC : KC;
      auto epi = [&](int row, int col0, const float (&acc)[16]) { float v[16];
#pragma unroll
          for (int j = 0; j < 16; ++j) v[j] = acc[j];
          const int c = (row >> 2) & 127;
          if (kv == 0 && col0 == 0 && c < NCMP) { const float* rp = ROPE + (16 * c + 31) * 16;
#pragma unroll
              for (int i = 0; i < 8; ++i) { const float cc = rp[i], s = rp[8 + i], x1 = v[i], x2 = v[i + 8]; v[i] = x1 * cc - x2 * s; v[i + 8] = x1 * s + x2 * cc; } }
          u32 w[8];
#pragma unroll
          for (int j = 0; j < 8; ++j) w[j] = (u32)f2bf(v[2 * j]) | ((u32)f2bf(v[2 * j + 1]) << 16);
          uint4* d = (uint4*)(dst + (size_t)row * 64 + col0); d[0] = make_uint4(w[0], w[1], w[2], w[3]); d[1] = make_uint4(w[4], w[5], w[6], w[7]); };
      gemm_simple(af, kv ? WCV2T : WCK2T, 256, 4096, 64, 256, ldsf, epi); }
    grid.sync();

    { volatile float* sc = (volatile float*)(ldsf + wib * 128);
      for (int task = gwave; task < MTOK * 4; task += nwaves) {
        const int row = task >> 2, g = task & 3, b = row >> 11, t = row & (SEQ - 1), cur = t >> 6;
        const bf16_t* prow = ACT + (size_t)row * N1;
        int nvalid = (t >= 31) ? ((t - 31) >> 4) + 1 : 0; if (nvalid > NCMP) nvalid = NCMP;
        float psum0 = 0.f, psum1 = 0.f, oc[4], os[4], ow[4];
#pragma unroll
        for (int r = 0; r < 4; ++r) { const bf16_t* qp = prow + (g * 4 + r) * 64; float lg0 = -1e30f, lg1 = -1e30f;
            if (lane < nvalid) lg0 = 0.125f * dot64(qp, KC + ((size_t)(b * 128 + lane) * 4 + g) * 64);
            if (lane + 64 < nvalid) lg1 = 0.125f * dot64(qp, KC + ((size_t)(b * 128 + lane + 64) * 4 + g) * 64);
            const float mx = wave_max(fmaxf(lg0, lg1));
            float p0 = (lane < nvalid) ? __expf(lg0 - mx) : 0.f, p1 = (lane + 64 < nvalid) ? __expf(lg1 - mx) : 0.f;
            const float sm = wave_sum(p0 + p1); const float inv = nvalid > 0 ? 1.f / sm : 0.f; p0 *= inv; p1 *= inv; psum0 += p0; psum1 += p1;
            float acc = 0.f;
            for (int c = 0; c < nvalid; ++c) { const float pc = __shfl(c < 64 ? p0 : p1, c & 63); acc += pc * bf2f(VC[((size_t)(b * 128 + c) * 4 + g) * 64 + lane]); }
            oc[r] = acc; }
        sc[lane] = psum0; sc[64 + lane] = psum1;
        asm volatile("s_waitcnt lgkmcnt(0)" ::: "memory");
        const int j = lane & 31; float imp = 0.f;
#pragma unroll
        for (int e = -1; e <= 3; ++e) { const int c = 4 * j + e; if (c >= 0 && c < NCMP) imp += sc[c]; }
        asm volatile("s_waitcnt lgkmcnt(0)" ::: "memory");
        const bool forced = (j == 0) || (j == cur) || (j == cur - 1); const bool causal = j <= cur;
        const float val = forced ? 1e6f : (causal ? imp : -1.f);
        int rank = 0;
        for (int jj = 0; jj < 32; ++jj) { const float vj = __shfl(val, jj); rank += ((vj > val) || (vj == val && jj < j)) ? 1 : 0; }
        const u32 mask = (u32)(__ballot(rank < 8) & 0xffffffffull);
#pragma unroll
        for (int r = 0; r < 4; ++r) { const bf16_t* qp = prow + (g * 4 + r) * 64;
            { float lg[8]; u32 mm = mask; float mx = -1e30f;
#pragma unroll
              for (int n = 0; n < 8; ++n) { const int jb = __builtin_ctz(mm); mm &= mm - 1; const int kpos = jb * 64 + lane;
                  lg[n] = (kpos <= t) ? 0.125f * dot64(qp, ACT + (size_t)(b * SEQ + kpos) * N1 + C1_KS + g * 64) : -1e30f; mx = fmaxf(mx, lg[n]); }
              mx = wave_max(mx); float sm = 0.f;
#pragma unroll
              for (int n = 0; n < 8; ++n) { lg[n] = __expf(lg[n] - mx); sm += lg[n]; }
              sm = wave_sum(sm); mm = mask; float acc = 0.f;
#pragma unroll
              for (int n = 0; n < 8; ++n) { const int jb = __builtin_ctz(mm); mm &= mm - 1; const bf16_t* vb = ACT + (size_t)(b * SEQ + jb * 64) * N1 + C1_VS + g * 64 + lane;
                  for (int key = 0; key < 64; ++key) { const float pk = __shfl(lg[n], key); acc += pk * bf2f(vb[(size_t)key * N1]); } }
              os[r] = acc / sm; }
            { float lg[8]; float mx = -1e30f;
#pragma unroll
              for (int n = 0; n < 8; ++n) { const int kpos = t - 511 + 64 * n + lane;
                  lg[n] = (kpos >= 0) ? 0.125f * dot64(qp, ACT + (size_t)(b * SEQ + kpos) * N1 + C1_KW + g * 64) : -1e30f; mx = fmaxf(mx, lg[n]); }
              mx = wave_max(mx); float sm = 0.f;
#pragma unroll
              for (int n = 0; n < 8; ++n) { lg[n] = __expf(lg[n] - mx); sm += lg[n]; }
              sm = wave_sum(sm); float acc = 0.f;
#pragma unroll
              for (int n = 0; n < 8; ++n) { const int k0 = t - 511 + 64 * n;
                  for (int key = 0; key < 64; ++key) { const int kpos = k0 + key; const float pk = __shfl(lg[n], key); if (kpos >= 0) acc += pk * bf2f(ACT[(size_t)(b * SEQ + kpos) * N1 + C1_VW + g * 64 + lane]); } }
              ow[r] = acc / sm; } }
#pragma unroll
        for (int r = 0; r < 4; ++r) { const int h = g * 4 + r; const float gc = sigmoidf_(bf2f(prow[C1_GATE + h * 3])), gs = sigmoidf_(bf2f(prow[C1_GATE + h * 3 + 1])), gw = sigmoidf_(bf2f(prow[C1_GATE + h * 3 + 2]));
            const float z = bf2f(prow[C1_Z + h * 64 + lane]); const float o = gc * oc[r] + gs * os[r] + gw * ow[r];
            AO[(size_t)row * DM + h * 64 + lane] = f2bf(o * z * sigmoidf_(z)); }
      } }
    grid.sync();

    { pg8::Gemm g{AO, WO1T, MTOK, DM, DM}; pg8::StaticOrder S; S.init(MTOK, DM, (int)gridDim.x, (int)blockIdx.x);
      pg8::EpiResid E{out, out, nullptr, DM};
      pg8::gemm_phase<pg8::EpiResid, pg8::StaticOrder, true, true>(ldsL, g, S, E); }
    grid.sync();
    for (int row = gwave; row < MTOK; row += nwaves) { float* xr = out + (size_t)row * DM; float4 v[4]; float ss = 0.f;
#pragma unroll
        for (int j = 0; j < 4; ++j) { v[j] = *(const float4*)(xr + j * 256 + lane * 4); ss += v[j].x * v[j].x + v[j].y * v[j].y + v[j].z * v[j].z + v[j].w * v[j].w; }
        ss = wave_sum(ss); const float rstd = rsqrtf(ss * (1.f / DM) + EPS);
#pragma unroll
        for (int j = 0; j < 4; ++j) { const float4 gg = *(const float4*)(final_g + j * 256 + lane * 4); float4 o; o.x = v[j].x * rstd * gg.x; o.y = v[j].y * rstd * gg.y; o.z = v[j].z * rstd * gg.z; o.w = v[j].w * rstd * gg.w; *(float4*)(xr + j * 256 + lane * 4) = o; } }
}

extern "C" void kernel_launch(void* const* d_in, const int* in_sizes, int n_in, void* d_out, int out_size, void* d_ws, size_t ws_size, hipStream_t stream) {
    constexpr size_t kDynLds = 147456;
    static int grid_blocks = 0;
    if (!grid_blocks) {
        int dev = 0, cus = 0, per_cu = 0;
        hipGetDevice(&dev);
        hipDeviceGetAttribute(&cus, hipDeviceAttributeMultiprocessorCount, dev);
        hipFuncSetAttribute((const void*)fwd_kernel, hipFuncAttributeMaxDynamicSharedMemorySize, (int)kDynLds);
        hipOccupancyMaxActiveBlocksPerMultiprocessor(&per_cu, (const void*)fwd_kernel, 512, kDynLds);
        if (per_cu < 1) per_cu = 1;
        if (per_cu > 1) per_cu = 1;
        grid_blocks = cus * per_cu;
        if (n_in != 14 || ws_size < WS_END) fprintf(stderr, "kernel_launch: unexpected n_in %d / ws_size %zu\n", n_in, ws_size);
    }
    Params p{};
    for (int i = 0; i < 14; ++i) p.in[i] = (const float*)d_in[i];
    p.out = (float*)d_out; p.ws = (unsigned char*)d_ws;
    void* args[] = {&p};
    hipError_t e = hipLaunchCooperativeKernel((const void*)fwd_kernel, dim3(grid_blocks), dim3(512), args, kDynLds, stream);
    if (e != hipSuccess) fprintf(stderr, "cooperative launch failed: %s (grid %d)\n", hipGetErrorString(e), grid_blocks);
}
```

```cpp
#include <hip/hip_runtime.h>
#include <hip/hip_cooperative_groups.h>
#include <cstdio>
#include <cstdint>
namespace cg = cooperative_groups;

typedef unsigned short bf16_t;
typedef unsigned int u32;

constexpr int DM = 1024, BATCH = 8, SEQ = 2048, MTOK = BATCH * SEQ;
constexpr int NH = 16, HD = 64;
constexpr int FOX_IN = 4 * DM + NH;
constexpr int NSA_IN = 3632;
constexpr int N0 = 4096;
constexpr int N1 = 3840;
constexpr int C1_Q = 0, C1_KC = 1024, C1_VC = 1280, C1_KS = 1536, C1_VS = 1792, C1_KW = 2048, C1_VW = 2304, C1_Z = 2560, C1_GATE = 3584;
constexpr int NCMP = 127, NCMP_P = 128;
constexpr float EPS = 1e-6f;

constexpr size_t MiB = 1u << 20;
constexpr size_t WS_CTL = 0;
constexpr size_t WS_W0T = 1 * MiB;
constexpr size_t WS_WO0T = 9 * MiB;
constexpr size_t WS_W1T = 11 * MiB;
constexpr size_t WS_WO1T = 19 * MiB;
constexpr size_t WS_WCK1T = 21 * MiB;
constexpr size_t WS_WCV1T = 22 * MiB;
constexpr size_t WS_WCK2T = 23 * MiB;
constexpr size_t WS_WCV2T = 23 * MiB + 65536;
constexpr size_t WS_CBIAS = 23 * MiB + 131072;
constexpr size_t WS_ROPE = 23 * MiB + 196608;
constexpr size_t WS_RS0 = 24 * MiB;
constexpr size_t WS_RS1 = 24 * MiB + 65536;
constexpr size_t WS_LOGF = 25 * MiB;
constexpr size_t WS_CUM = 26 * MiB;
constexpr size_t WS_KC = 27 * MiB;
constexpr size_t WS_VC = 27 * MiB + 524288;
constexpr size_t WS_HID = 28 * MiB;
constexpr size_t WS_XB = 32 * MiB;
constexpr size_t WS_ACT = 64 * MiB;
constexpr size_t WS_AO = 192 * MiB;
constexpr size_t WS_END = 224 * MiB;

struct Params { const float* in[14]; float* out; unsigned char* ws; };

__device__ __forceinline__ float bf2f(bf16_t v) { return __uint_as_float((u32)v << 16); }
__device__ __forceinline__ bf16_t f2bf(float f) { u32 u = __float_as_uint(f); return (bf16_t)((u + 0x7fffu + ((u >> 16) & 1u)) >> 16); }
__device__ __forceinline__ float lo_f(u32 w) { return __uint_as_float(w << 16); }
__device__ __forceinline__ float hi_f(u32 w) { return __uint_as_float(w & 0xffff0000u); }
__device__ __forceinline__ float wave_sum(float v) {
#pragma unroll
    for (int o = 1; o < 64; o <<= 1) v += __shfl_xor(v, o);
    return v;
}
__device__ __forceinline__ float wave_max(float v) {
#pragma unroll
    for (int o = 1; o < 64; o <<= 1) v = fmaxf(v, __shfl_xor(v, o));
    return v;
}
__device__ __forceinline__ float sigmoidf_(float x) { return 1.f / (1.f + __expf(-x)); }
__device__ __forceinline__ float dot64(const bf16_t* qu, const bf16_t* kp) {
    float s = 0.f;
#pragma unroll
    for (int i = 0; i < 8; ++i) {
        const uint4 a = ((const uint4*)qu)[i], b = ((const uint4*)kp)[i];
        s += lo_f(a.x) * lo_f(b.x); s += hi_f(a.x) * hi_f(b.x);
        s += lo_f(a.y) * lo_f(b.y); s += hi_f(a.y) * hi_f(b.y);
        s += lo_f(a.z) * lo_f(b.z); s += hi_f(a.z) * hi_f(b.z);
        s += lo_f(a.w) * lo_f(b.w); s += hi_f(a.w) * hi_f(b.w);
    }
    return s;
}

namespace pg8 {
#define PG8_LAS __attribute__((address_space(3)))
typedef PG8_LAS unsigned char* PG8_LAS_T;
typedef unsigned short bf16_t;
typedef short bf16x8 __attribute__((ext_vector_type(8)));
typedef float f32x4 __attribute__((ext_vector_type(4)));
typedef unsigned u32x4 __attribute__((ext_vector_type(4)));
constexpr int BM = 256, BK = 64, HALF = 128, HTB = HALF * BK * 2  , STAGE_BYTES = 8 * HTB, NXCD = 8, WGM = 8;

__host__ __device__ __forceinline__ int lds_byte(int r, int c) { const int st = (r >> 4) * 2 + (c >> 5), rr = r & 15, cc = c & 31, ob = rr * 64 + cc * 2; return st * 1024 + (ob ^ (((ob >> 9) & 1) << 5)); }
__host__ __device__ __forceinline__ void stage_rc(int b, int& R, int& C) { const int st = b / 1024, sb = b % 1024, swz = sb ^ (((sb >> 9) & 1) << 5); R = (st >> 1) * 16 + swz / 64; C = (st & 1) * 32 + (swz % 64) / 2; }
__host__ __device__ __forceinline__ int perm32(int rho) { const int n = rho >> 4, i = rho & 15; return 8 * (i >> 2) + 4 * n + (i & 3); }

struct Unit { int pm, pn; };
struct Gemm { const bf16_t* A; const bf16_t* Bt; int M, N, K; };

struct StaticOrder {
    int nM, nN, nwg, G, c;
    __host__ __device__ void init(int M, int N, int G_, int c_) { nM = M / BM; nN = N / BM; nwg = nM * nN; G = G_; c = c_; }
    __host__ __device__ bool next(int i, Unit& u) const {
        const long L = (long)i * G + c; if (L >= nwg) return false;
        int wgid = (int)L; { const int q = nwg / NXCD, r = nwg % NXCD, xcd = wgid % NXCD, off = wgid / NXCD; wgid = (xcd < r ? xcd * (q + 1) : r * (q + 1) + (xcd - r) * q) + off; }
        const int nig = WGM * nN, gid = wgid / nig, fm = gid * WGM, gsz = (nM - fm) < WGM ? (nM - fm) : WGM;
        u.pm = fm + ((wgid % nig) % gsz); u.pn = (wgid % nig) / gsz; return true;
    }
    __device__ __forceinline__ void a_ready(const Unit&) const {}
    __device__ __forceinline__ void done(const Unit&) const {}
};

__device__ __forceinline__ unsigned cvt_pk_bf16(float lo, float hi) { unsigned r; asm volatile("v_cvt_pk_bf16_f32 %0, %1, %2" : "=v"(r) : "v"(lo), "v"(hi)); return r; }
typedef float f32x2 __attribute__((ext_vector_type(2)));
__device__ __forceinline__ f32x2 gelu_pk(f32x2 v) {
    const f32x2 av = __builtin_elementwise_abs(v), d = av * 0.2316418882f + 1.0f;
    f32x2 t; t.x = __builtin_amdgcn_rcpf(d.x); t.y = __builtin_amdgcn_rcpf(d.y);
    f32x2 q = t * 0.5307027145f + (-0.7265760135f); q = q * t + 0.7107068705f; q = q * t + (-0.142248368f); q = q * t + 0.127414796f; q = q * t;
    const f32x2 s = (v * v) * (-0.72134752044f);
    f32x2 e; e.x = __builtin_amdgcn_exp2f(s.x); e.y = __builtin_amdgcn_exp2f(s.y);
    const f32x2 m = v * (q * e), r = v - m;
    f32x2 o; o.x = v.x < 0.f ? m.x : r.x; o.y = v.y < 0.f ? m.y : r.y; return o;
}

template <int ACT  > struct EpiBf16 {
    static constexpr bool PERM = true, AFTER_DRAIN = false; static_assert(ACT == 0 || ACT == 1, "EpiBf16: ACT is 0 (none) or 1 (gelu_pk)");
    bf16_t* O; int ldc; const float* bias; int split_cols; size_t split_stride; float scale0;
    __device__ __forceinline__ void operator()(const f32x4 (&acc)[2][2][4][2], const Unit& u, int wr, int wc, int fr, int fq) const {
        const int row0 = u.pm * BM + wr * 64 + fr; int colt = u.pn * BM; bf16_t* base = O;
        float sc = 1.f; if (split_cols) { const int t = colt / split_cols; base += (size_t)t * split_stride; colt -= t * split_cols; if (t == 0) sc = scale0; }
        const int col0 = colt + wc * 32 + 8 * fq, bcol0 = u.pn * BM + wc * 32 + 8 * fq;
        f32x4 bv[2][2];
#pragma unroll
        for (int bj = 0; bj < 2; ++bj)
#pragma unroll
            for (int n = 0; n < 2; ++n) bv[bj][n] = bias ? *(const f32x4*)(bias + bcol0 + bj * HALF + 4 * n) : (f32x4){0.f, 0.f, 0.f, 0.f};
#pragma unroll
        for (int ai = 0; ai < 2; ++ai)
#pragma unroll
            for (int m = 0; m < 4; ++m) { bf16_t* rowp = base + (size_t)(row0 + ai * HALF + m * 16) * ldc + col0;
#pragma unroll
                for (int bj = 0; bj < 2; ++bj) { f32x4 v0 = acc[ai][bj][m][0] + bv[bj][0], v1 = acc[ai][bj][m][1] + bv[bj][1];
                    if (ACT == 1) { f32x2 a = gelu_pk((f32x2){v0[0], v0[1]}), b = gelu_pk((f32x2){v0[2], v0[3]}), c = gelu_pk((f32x2){v1[0], v1[1]}), d = gelu_pk((f32x2){v1[2], v1[3]});
                        v0 = (f32x4){a.x, a.y, b.x, b.y}; v1 = (f32x4){c.x, c.y, d.x, d.y}; }
                    v0 = v0 * sc; v1 = v1 * sc; u32x4 w; w.x = cvt_pk_bf16(v0[0], v0[1]); w.y = cvt_pk_bf16(v0[2], v0[3]); w.z = cvt_pk_bf16(v1[0], v1[1]); w.w = cvt_pk_bf16(v1[2], v1[3]);
                    *(u32x4*)(rowp + bj * HALF) = w; } }
    }
};

struct PanelStats {
    unsigned* xbuf;
    unsigned* cnt;
    unsigned* tmo;
    int ntn; float eps;
    unsigned code;
    __device__ __forceinline__ bool run(const f32x4 (&v)[2][2][4][2], const Unit& u, int wr, int wc, int fr, int fq, PG8_LAS unsigned char* lds, int wid, int lane) const {
        typedef float f32x2v __attribute__((ext_vector_type(2)));
        PG8_LAS f32x2v* P = (PG8_LAS f32x2v*)lds;
        PG8_LAS f32x2v* S = (PG8_LAS f32x2v*)(lds + 8192);
        PG8_LAS unsigned* flag = (PG8_LAS unsigned*)(lds + 8192 + 2048);
#pragma unroll
        for (int ai = 0; ai < 2; ++ai)
#pragma unroll
            for (int m = 0; m < 4; ++m) {
                float s = 0.f;
#pragma unroll
                for (int bj = 0; bj < 2; ++bj)
#pragma unroll
                    for (int n = 0; n < 2; ++n) { const f32x4 x = v[ai][bj][m][n]; s += (x[0] + x[1]) + (x[2] + x[3]); }
                s += __shfl_xor(s, 16); s += __shfl_xor(s, 32);
                const float mw = s * (1.0f / 64.0f); float q = 0.f;
#pragma unroll
                for (int bj = 0; bj < 2; ++bj)
#pragma unroll
                    for (int n = 0; n < 2; ++n) { const f32x4 d = v[ai][bj][m][n] - mw; q += (d[0] * d[0] + d[1] * d[1]) + (d[2] * d[2] + d[3] * d[3]); }
                q += __shfl_xor(q, 16); q += __shfl_xor(q, 32);
                if (fq == 0) P[(ai * HALF + wr * 64 + m * 16 + fr) * 4 + wc] = (f32x2v){mw, q};
            }
        asm volatile("s_waitcnt lgkmcnt(0)" ::: "memory"); __builtin_amdgcn_s_barrier(); asm volatile("" ::: "memory");
#if defined(BROKEN_EXCHANGE_NO_WAIT)
#warning BROKEN CONTROL BUILD: the row-statistics exchange does not wait; results are wrong by design
        if (blockIdx.x >= 64) { const long long t0_ = clock64(); while (clock64() - t0_ < 60000) __builtin_amdgcn_s_sleep(8); }
#endif
        const int row = wid * 32 + (lane & 31);
        if (lane < 32) {
            const f32x2v a = P[row * 4 + 0], b = P[row * 4 + 1], c = P[row * 4 + 2], d = P[row * 4 + 3];
            const float mt = (a.x + b.x + c.x + d.x) * 0.25f;
            const float da = a.x - mt, db = b.x - mt, dc = c.x - mt, dd = d.x - mt;
            const float m2 = (a.y + b.y) + (c.y + d.y) + 64.0f * ((da * da + db * db) + (dc * dc + dd * dd));
            unsigned long long* slot = (unsigned long long*)xbuf + ((size_t)(u.pm * BM + row) * 4 + u.pn);
            __hip_atomic_store(slot, ((unsigned long long)__float_as_uint(m2) << 32) | __float_as_uint(mt), __ATOMIC_RELAXED, __HIP_MEMORY_SCOPE_AGENT);
        }
        asm volatile("s_waitcnt vmcnt(0)" ::: "memory");
        if (lane == 0) __hip_atomic_fetch_add(cnt + 64 * u.pm, 1u, __ATOMIC_RELAXED, __HIP_MEMORY_SCOPE_AGENT);
        if (wid == 0) {
            bool dead = false; const unsigned long long t0 = __builtin_amdgcn_s_memrealtime(); const unsigned want = 8u * (unsigned)ntn;
            for (;;) {
#if defined(BROKEN_EXCHANGE_NO_WAIT)
                break;
#endif
                if ((unsigned)__builtin_amdgcn_readfirstlane(__hip_atomic_load(cnt + 64 * u.pm, __ATOMIC_RELAXED, __HIP_MEMORY_SCOPE_AGENT)) >= want) break;
                if (__builtin_amdgcn_s_memrealtime() - t0 > 2000000ull) {
                    if (lane == 0) { unsigned expect = 0u; __hip_atomic_compare_exchange_strong(tmo + 1, &expect, code | (unsigned)(u.pm & 0xff), __ATOMIC_RELAXED, __ATOMIC_RELAXED, __HIP_MEMORY_SCOPE_AGENT);
                                     __hip_atomic_store(tmo, 1u, __ATOMIC_RELAXED, __HIP_MEMORY_SCOPE_AGENT); }
                    dead = true; break; }
                __builtin_amdgcn_s_sleep(2);
            }
            __builtin_amdgcn_fence(__ATOMIC_ACQUIRE, "agent");
            if (lane == 0) flag[0] = dead ? 1u : 0u;
        }
        asm volatile("s_waitcnt vmcnt(0) lgkmcnt(0)" ::: "memory"); __builtin_amdgcn_s_barrier(); asm volatile("" ::: "memory");
        const bool bad = flag[0] != 0u;
        if (lane < 32) {
            const unsigned long long* slot = (const unsigned long long*)xbuf + (size_t)(u.pm * BM + row) * 4; float mt[4], m2[4]; float ms = 0.f;
#pragma unroll
            for (int t = 0; t < 4; ++t) { if (t < ntn) { const unsigned long long w = __hip_atomic_load(slot + t, __ATOMIC_RELAXED, __HIP_MEMORY_SCOPE_AGENT); mt[t] = __uint_as_float((unsigned)w); m2[t] = __uint_as_float((unsigned)(w >> 32)); } else { mt[t] = 0.f; m2[t] = 0.f; } ms += mt[t]; }
            const float mean = ms / (float)ntn; float q = 0.f;
#pragma unroll
            for (int t = 0; t < 4; ++t) if (t < ntn) { const float dm = mt[t] - mean; q += m2[t] + 256.0f * dm * dm; }
            S[row] = (f32x2v){mean, 1.0f / sqrtf(q / (256.0f * (float)ntn) + eps)};
        }
        asm volatile("s_waitcnt lgkmcnt(0)" ::: "memory"); __builtin_amdgcn_s_barrier(); asm volatile("" ::: "memory");
        return bad;
    }
};
struct EpiLnRes {
    static constexpr bool PERM = false, AFTER_DRAIN = true;
    const float* base; float* out; int ldc; const float* bias; PanelStats st; unsigned poison;
    __device__ __forceinline__ void fused(f32x4 (&acc)[2][2][4][2], const Unit& u, int wr, int wc, int fr, int fq, PG8_LAS unsigned char* lds, int wid, int lane) const {
        typedef float f32x2v __attribute__((ext_vector_type(2)));
        const PG8_LAS f32x2v* S = (const PG8_LAS f32x2v*)(lds + 8192);
        const int col0 = u.pn * BM + wc * 32 + 4 * fq;
#pragma unroll
        for (int bj = 0; bj < 2; ++bj)
#pragma unroll
            for (int n = 0; n < 2; ++n) { const f32x4 bv = bias ? *(const f32x4*)(bias + col0 + bj * HALF + n * 16) : (f32x4){0.f, 0.f, 0.f, 0.f};
#pragma unroll
                for (int ai = 0; ai < 2; ++ai)
#pragma unroll
                    for (int m = 0; m < 4; ++m) acc[ai][bj][m][n] += bv; }
        f32x4 pre[4][2][2];
#pragma unroll
        for (int m = 0; m < 4; ++m) { const size_t off = (size_t)(u.pm * BM + wr * 64 + m * 16 + fr) * ldc + col0;
#pragma unroll
            for (int bj = 0; bj < 2; ++bj)
#pragma unroll
                for (int n = 0; n < 2; ++n) pre[m][bj][n] = *(const f32x4*)(base + off + bj * HALF + n * 16); }
        const bool bad = st.run(acc, u, wr, wc, fr, fq, lds, wid, lane) || poison != 0u;
        const float qnan = __builtin_nanf("");
#pragma unroll
        for (int ai = 0; ai < 2; ++ai)
#pragma unroll
            for (int m = 0; m < 4; ++m) { const int r = ai * HALF + wr * 64 + m * 16 + fr; const f32x2v sr = S[r]; const size_t off = (size_t)(u.pm * BM + r) * ldc + col0;
#pragma unroll
                for (int bj = 0; bj < 2; ++bj)
#pragma unroll
                    for (int n = 0; n < 2; ++n) { const f32x4 bs = ai == 0 ? pre[m][bj][n] : *(const f32x4*)(base + off + bj * HALF + n * 16); f32x4 o = bs + (acc[ai][bj][m][n] - sr.x) * sr.y;
                        if (bad) o = (f32x4){qnan, qnan, qnan, qnan}; *(f32x4*)(out + off + bj * HALF + n * 16) = o; }
                if (m & 1) asm volatile("" ::: "memory"); }
    }
};
struct EpiLnResLn {
    static constexpr bool PERM = false, AFTER_DRAIN = true;
    const float* base; float* out; bf16_t* xn; int ldc; const float* bias; PanelStats st1, st2; unsigned poison;
    __device__ __forceinline__ void fused(f32x4 (&acc)[2][2][4][2], const Unit& u, int wr, int wc, int fr, int fq, PG8_LAS unsigned char* lds, int wid, int lane) const {
        typedef float f32x2v __attribute__((ext_vector_type(2))); typedef unsigned u32x2v __attribute__((ext_vector_type(2)));
        const PG8_LAS f32x2v* S = (const PG8_LAS f32x2v*)(lds + 8192);
        const int col0 = u.pn * BM + wc * 32 + 4 * fq;
#pragma unroll
        for (int bj = 0; bj < 2; ++bj)
#pragma unroll
            for (int n = 0; n < 2; ++n) { const f32x4 bv = bias ? *(const f32x4*)(bias + col0 + bj * HALF + n * 16) : (f32x4){0.f, 0.f, 0.f, 0.f};
#pragma unroll
                for (int ai = 0; ai < 2; ++ai)
#pragma unroll
                    for (int m = 0; m < 4; ++m) acc[ai][bj][m][n] += bv; }
        bool bad = st1.run(acc, u, wr, wc, fr, fq, lds, wid, lane) || poison != 0u;
        const float qnan = __builtin_nanf("");
#pragma unroll
        for (int ai = 0; ai < 2; ++ai)
#pragma unroll
            for (int m = 0; m < 4; ++m) { const int r = ai * HALF + wr * 64 + m * 16 + fr; const f32x2v sr = S[r]; const size_t off = (size_t)(u.pm * BM + r) * ldc + col0;
#pragma unroll
                for (int bj = 0; bj < 2; ++bj)
#pragma unroll
                    for (int n = 0; n < 2; ++n) { const f32x4 bs = *(const f32x4*)(base + off + bj * HALF + n * 16); acc[ai][bj][m][n] = bs + (acc[ai][bj][m][n] - sr.x) * sr.y; }
                asm volatile("" : "+v"(acc[ai][0][m][0]), "+v"(acc[ai][0][m][1]), "+v"(acc[ai][1][m][0]), "+v"(acc[ai][1][m][1]));
                if (m & 1) asm volatile("" ::: "memory"); }
        const bool bad1 = bad;
        bad = st2.run(acc, u, wr, wc, fr, fq, lds, wid, lane) || bad;
#pragma unroll
        for (int ai = 0; ai < 2; ++ai)
#pragma unroll
            for (int m = 0; m < 4; ++m) { const int r = ai * HALF + wr * 64 + m * 16 + fr; const f32x2v sr = S[r]; const size_t off = (size_t)(u.pm * BM + r) * ldc + col0;
#pragma unroll
                for (int bj = 0; bj < 2; ++bj)
#pragma unroll
                    for (int n = 0; n < 2; ++n) { const f32x4 x1 = acc[ai][bj][m][n]; *(f32x4*)(out + off + bj * HALF + n * 16) = bad1 ? (f32x4){qnan, qnan, qnan, qnan} : x1;
                        const f32x4 o = (x1 - sr.x) * sr.y; u32x2v w; w.x = cvt_pk_bf16(o[0], o[1]); w.y = cvt_pk_bf16(o[2], o[3]);
                        if (bad) { w.x = 0x7fc07fc0u; w.y = 0x7fc07fc0u; } *(u32x2v*)(xn + off + bj * HALF + n * 16) = w; }
                asm volatile("" ::: "memory"); }
    }
};

template <class Epi, class Sched, bool ALIGN_EPI = false, bool SP2 = false>
__device__ __forceinline__ void gemm_phase(PG8_LAS unsigned char* lds, const Gemm g, const Sched& S, const Epi& E) {
    int tid_ = threadIdx.x; asm volatile("" : "+v"(tid_));
    const int tid = tid_, wid = __builtin_amdgcn_readfirstlane(tid >> 6), lane = tid & 63, wr = wid >> 2, wc = wid & 3, fr = lane & 15, fq = lane >> 4;
    const int K = g.K, nt = K / BK;
    unsigned voffA[2], voffB[2];
#pragma unroll
    for (int i = 0; i < 2; ++i) { int R, C; stage_rc(tid * 16 + i * 8192, R, C); const int Rb = Epi::PERM ? ((R & ~31) + perm32(R & 31)) : R;
        voffA[i] = (unsigned)(R * K + C) * 2u; voffB[i] = (unsigned)(Rb * K + C) * 2u; }
    const size_t kstep = (size_t)(BK * 2);
    const size_t hstep = (size_t)HALF * K * 2;
    const size_t tstep = 2 * hstep;
    const unsigned ldsw = (unsigned)wid * 1024u;
    const int aoff = lds_byte(wr * 64 + fr, fq * 8), boff = lds_byte(wc * 32 + fr, fq * 8);
#define PG8_SA(b, h) (((b) * 2 + (h)) * HTB)
#define PG8_SB(b, h) ((4 + (b) * 2 + (h)) * HTB)
#define PG8_STAGE(bufoff, gbase, voff) do { _Pragma("unroll") for (int _i = 0; _i < 2; ++_i) \
        __builtin_amdgcn_global_load_lds((const unsigned*)((const char*)(gbase) + (voff)[_i]), (PG8_LAS unsigned*)(lds + (bufoff) + ldsw + _i * 8192), 16, 0, 0); } while (0)
#define PG8_LDA(dst, b, h) do { _Pragma("unroll") for (int m = 0; m < 4; ++m) _Pragma("unroll") for (int k = 0; k < 2; ++k) dst[m][k] = *(const PG8_LAS bf16x8*)(lds + PG8_SA(b, h) + aoff + m * 2048 + k * 1024); } while (0)
#define PG8_LDB(dst, b, h) do { _Pragma("unroll") for (int n = 0; n < 2; ++n) _Pragma("unroll") for (int k = 0; k < 2; ++k) dst[n][k] = *(const PG8_LAS bf16x8*)(lds + PG8_SB(b, h) + boff + n * 2048 + k * 1024); } while (0)
#define PG8_MMA(ai, bj, At, Bt) do { __builtin_amdgcn_s_setprio(1); _Pragma("unroll") for (int m = 0; m < 4; ++m) _Pragma("unroll") for (int n = 0; n < 2; ++n) _Pragma("unroll") for (int k = 0; k < 2; ++k) \
        acc[ai][bj][m][n] = __builtin_amdgcn_mfma_f32_16x16x32_bf16(Bt[n][k], At[m][k], acc[ai][bj][m][n], 0, 0, 0); __builtin_amdgcn_s_setprio(0); } while (0)
#define PG8_WAIT_V(n) asm volatile("s_waitcnt vmcnt(" #n ")" ::: "memory")
#define PG8_WAIT_L(n) asm volatile("s_waitcnt lgkmcnt(" #n ")" ::: "memory")
#define PG8_BAR __builtin_amdgcn_s_barrier()
#define PG8_SCHED __builtin_amdgcn_sched_barrier(0)
    Unit cur, nxt; int ui = 0;
    if (!S.next(0, cur)) return;
    f32x4 acc[2][2][4][2];
#pragma unroll
    for (int a = 0; a < 2; ++a)
#pragma unroll
        for (int b = 0; b < 2; ++b)
#pragma unroll
            for (int m = 0; m < 4; ++m)
#pragma unroll
                for (int n = 0; n < 2; ++n) acc[a][b][m][n] = (f32x4){0.f, 0.f, 0.f, 0.f};
    bf16x8 At[4][2], B0[2][2], B1[2][2];
    const char* cA = (const char*)g.A + (size_t)cur.pm * tstep; const char* cB = (const char*)g.Bt + (size_t)cur.pn * tstep;
    S.a_ready(cur);
    if constexpr (SP2) {
        PG8_STAGE(PG8_SB(0, 0), cB, voffB); PG8_STAGE(PG8_SB(0, 1), cB + hstep, voffB); PG8_STAGE(PG8_SA(0, 0), cA, voffA); PG8_STAGE(PG8_SA(0, 1), cA + hstep, voffA);
        if (wr == 1) PG8_BAR;
        PG8_WAIT_V(2); PG8_BAR;
        PG8_STAGE(PG8_SB(1, 0), cB + kstep, voffB); PG8_STAGE(PG8_SA(1, 0), cA + kstep, voffA); PG8_STAGE(PG8_SB(1, 1), cB + hstep + kstep, voffB);
        PG8_WAIT_V(6); PG8_BAR;
    } else {
        PG8_STAGE(PG8_SB(0, 0), cB, voffB); PG8_STAGE(PG8_SA(0, 0), cA, voffA); PG8_STAGE(PG8_SB(0, 1), cB + hstep, voffB); PG8_STAGE(PG8_SA(0, 1), cA + hstep, voffA);
        if (wr == 1) PG8_BAR;
        PG8_WAIT_V(4); PG8_BAR;
        PG8_STAGE(PG8_SB(1, 0), cB + kstep, voffB); PG8_STAGE(PG8_SA(1, 0), cA + kstep, voffA); PG8_STAGE(PG8_SB(1, 1), cB + hstep + kstep, voffB);
        PG8_WAIT_V(6); PG8_BAR;
    }
    for (;;) {
        const bool has_next = S.next(ui + 1, nxt);
        const char* nA = has_next ? (const char*)g.A + (size_t)nxt.pm * tstep : cA; const char* nB = has_next ? (const char*)g.Bt + (size_t)nxt.pn * tstep : cB;
        for (int t = 0; t < nt; t += 2) {
            const bool last = (t == nt - 2);
            const char* a1 = cA + (size_t)(t + 1) * kstep;
            const char* a2 = last ? nA : cA + (size_t)(t + 2) * kstep; const char* b2 = last ? nB : cB + (size_t)(t + 2) * kstep;
            const char* a3 = a2 + kstep; const char* b3 = b2 + kstep;
            if (last && has_next) S.a_ready(nxt);
            if constexpr (SP2) {
            PG8_LDB(B0, 0, 0); PG8_LDB(B1, 0, 1); PG8_SCHED; PG8_LDA(At, 0, 0); PG8_STAGE(PG8_SA(1, 1), a1 + hstep, voffA);
            PG8_WAIT_V(8); PG8_WAIT_L(0); PG8_BAR; PG8_MMA(0, 0, At, B0); PG8_MMA(0, 1, At, B1); PG8_BAR; PG8_SCHED;
            PG8_LDA(At, 0, 1); PG8_STAGE(PG8_SB(0, 0), b2, voffB); PG8_STAGE(PG8_SB(0, 1), b2 + hstep, voffB); PG8_STAGE(PG8_SA(0, 0), a2, voffA);
            PG8_WAIT_V(8); PG8_WAIT_L(0); PG8_BAR; PG8_MMA(1, 0, At, B0); PG8_MMA(1, 1, At, B1); PG8_BAR; PG8_SCHED;
            PG8_LDB(B0, 1, 0); PG8_LDB(B1, 1, 1); PG8_SCHED; PG8_LDA(At, 1, 0); PG8_STAGE(PG8_SA(0, 1), a2 + hstep, voffA);
            PG8_WAIT_V(8); PG8_WAIT_L(0); PG8_BAR; PG8_MMA(0, 0, At, B0); PG8_MMA(0, 1, At, B1); PG8_BAR; PG8_SCHED;
            PG8_LDA(At, 1, 1); PG8_STAGE(PG8_SB(1, 0), b3, voffB); PG8_STAGE(PG8_SB(1, 1), b3 + hstep, voffB); PG8_STAGE(PG8_SA(1, 0), a3, voffA);
            PG8_WAIT_V(8); PG8_WAIT_L(0); PG8_BAR; PG8_MMA(1, 0, At, B0); PG8_MMA(1, 1, At, B1); PG8_BAR; PG8_SCHED;
            } else {
            PG8_LDB(B0, 0, 0); PG8_SCHED; PG8_LDA(At, 0, 0); PG8_STAGE(PG8_SA(1, 1), a1 + hstep, voffA);
            PG8_WAIT_L(8); PG8_BAR; PG8_WAIT_L(0); PG8_MMA(0, 0, At, B0); PG8_BAR; PG8_SCHED;
            PG8_LDB(B1, 0, 1); PG8_STAGE(PG8_SB(0, 0), b2, voffB);
            PG8_BAR; PG8_WAIT_L(0); PG8_MMA(0, 1, At, B1); PG8_BAR;
            PG8_LDA(At, 0, 1); PG8_STAGE(PG8_SA(0, 0), a2, voffA);
            PG8_BAR; PG8_WAIT_L(0); PG8_MMA(1, 0, At, B0); PG8_BAR; PG8_SCHED;
            PG8_STAGE(PG8_SB(0, 1), b2 + hstep, voffB);
            PG8_WAIT_V(6); PG8_BAR; PG8_MMA(1, 1, At, B1); PG8_BAR;
            PG8_LDB(B0, 1, 0); PG8_SCHED; PG8_LDA(At, 1, 0); PG8_STAGE(PG8_SA(0, 1), a2 + hstep, voffA);
            PG8_WAIT_L(8); PG8_BAR; PG8_WAIT_L(0); PG8_MMA(0, 0, At, B0); PG8_BAR; PG8_SCHED;
            PG8_LDB(B1, 1, 1); PG8_STAGE(PG8_SB(1, 0), b3, voffB);
            PG8_BAR; PG8_WAIT_L(0); PG8_MMA(0, 1, At, B1); PG8_BAR;
            PG8_LDA(At, 1, 1); PG8_STAGE(PG8_SA(1, 0), a3, voffA);
            PG8_BAR; PG8_WAIT_L(0); PG8_MMA(1, 0, At, B0); PG8_BAR; PG8_SCHED;
            PG8_STAGE(PG8_SB(1, 1), b3 + hstep, voffB);
            PG8_WAIT_V(6); PG8_BAR; PG8_MMA(1, 1, At, B1); PG8_BAR;
            }
        }
        if constexpr (ALIGN_EPI) { if (wr == 0) PG8_BAR; }
        if constexpr (!Epi::AFTER_DRAIN) { E(acc, cur, wr, wc, fr, fq); S.done(cur); }
        if (!has_next) break;
#pragma unroll
        for (int a = 0; a < 2; ++a)
#pragma unroll
            for (int b = 0; b < 2; ++b)
#pragma unroll
                for (int m = 0; m < 4; ++m)
#pragma unroll
                    for (int n = 0; n < 2; ++n) acc[a][b][m][n] = (f32x4){0.f, 0.f, 0.f, 0.f};
        cur = nxt; cA = nA; cB = nB; ++ui;
        if constexpr (ALIGN_EPI) { if (wr == 1) PG8_BAR; }
    }
    PG8_WAIT_V(0);
    if constexpr (!ALIGN_EPI) { if (wr == 0) PG8_BAR; }
    PG8_BAR;
    if constexpr (Epi::AFTER_DRAIN) { E.fused(acc, cur, wr, wc, fr, fq, lds, wid, lane); S.done(cur); }
#undef PG8_SA
#undef PG8_SB
#undef PG8_STAGE
#undef PG8_LDA
#undef PG8_LDB
#undef PG8_MMA
#undef PG8_WAIT_V
#undef PG8_WAIT_L
#undef PG8_BAR
#undef PG8_SCHED
}
}


namespace pg8 {
struct EpiProj {
    static constexpr bool PERM = true, AFTER_DRAIN = false;
    bf16_t* O; int ldc; const float* rs; const float* rope; unsigned rope_mask; unsigned qmask; float qscale;
    __device__ __forceinline__ void operator()(const f32x4 (&acc)[2][2][4][2], const Unit& u, int wr, int wc, int fr, int fq) const {
        const int row0 = u.pm * BM + wr * 64 + fr; const int col0 = u.pn * BM + wc * 32 + 8 * fq;
        const bool roped = ((rope_mask >> u.pn) & 1u) && ((wc & 1) == 0); const float qs = ((qmask >> u.pn) & 1u) ? qscale : 1.f;
#pragma unroll
        for (int ai = 0; ai < 2; ++ai)
#pragma unroll
            for (int m = 0; m < 4; ++m) { const int row = row0 + ai * HALF + m * 16; const float s = rs[row] * qs; bf16_t* rowp = O + (size_t)row * ldc + col0;
                f32x4 cs0 = {1.f, 1.f, 1.f, 1.f}, cs1 = cs0, sn0 = {0.f, 0.f, 0.f, 0.f}, sn1 = sn0;
                if (roped) { const float* rp = rope + (row & 2047) * 16; cs0 = *(const f32x4*)(rp); cs1 = *(const f32x4*)(rp + 4); sn0 = *(const f32x4*)(rp + 8); sn1 = *(const f32x4*)(rp + 12);
                    if (fq == 0) { sn0 = -sn0; sn1 = -sn1; } if (fq >= 2) { cs0 = (f32x4){1.f, 1.f, 1.f, 1.f}; cs1 = cs0; sn0 = (f32x4){0.f, 0.f, 0.f, 0.f}; sn1 = sn0; } }
#pragma unroll
                for (int bj = 0; bj < 2; ++bj) { f32x4 v0 = acc[ai][bj][m][0] * s, v1 = acc[ai][bj][m][1] * s;
                    if (roped) { f32x4 o0, o1;
#pragma unroll
                        for (int e = 0; e < 4; ++e) { o0[e] = __shfl_xor(v0[e], 16); o1[e] = __shfl_xor(v1[e], 16); }
                        v0 = v0 * cs0 + o0 * sn0; v1 = v1 * cs1 + o1 * sn1; }
                    u32x4 w; w.x = cvt_pk_bf16(v0[0], v0[1]); w.y = cvt_pk_bf16(v0[2], v0[3]); w.z = cvt_pk_bf16(v1[0], v1[1]); w.w = cvt_pk_bf16(v1[2], v1[3]);
                    *(u32x4*)(rowp + bj * HALF) = w; } }
    }
};
struct EpiResid {
    static constexpr bool PERM = true, AFTER_DRAIN = false;
    const float* base; float* out; bf16_t* ob; int ldc;
    __device__ __forceinline__ void operator()(const f32x4 (&acc)[2][2][4][2], const Unit& u, int wr, int wc, int fr, int fq) const {
        const int row0 = u.pm * BM + wr * 64 + fr; const int col0 = u.pn * BM + wc * 32 + 8 * fq;
#pragma unroll
        for (int ai = 0; ai < 2; ++ai)
#pragma unroll
            for (int m = 0; m < 4; ++m) { const size_t off = (size_t)(row0 + ai * HALF + m * 16) * ldc + col0;
#pragma unroll
                for (int bj = 0; bj < 2; ++bj) { const f32x4 b0 = *(const f32x4*)(base + off + bj * HALF), b1 = *(const f32x4*)(base + off + bj * HALF + 4);
                    const f32x4 v0 = b0 + acc[ai][bj][m][0], v1 = b1 + acc[ai][bj][m][1];
                    *(f32x4*)(out + off + bj * HALF) = v0; *(f32x4*)(out + off + bj * HALF + 4) = v1;
                    if (ob) { u32x4 w; w.x = cvt_pk_bf16(v0[0], v0[1]); w.y = cvt_pk_bf16(v0[2], v0[3]); w.z = cvt_pk_bf16(v1[0], v1[1]); w.w = cvt_pk_bf16(v1[2], v1[3]); *(u32x4*)(ob + off + bj * HALF) = w; } } }
    }
};
}

struct APlain { const bf16_t* A; int lda; __device__ __forceinline__ const bf16_t* operator()(int m, int k) const { return A + (size_t)m * lda + k; } };
struct ACmp { const bf16_t* act; int col0; __device__ __forceinline__ const bf16_t* operator()(int m, int k) const {
    const int g = m & 3, c0 = (m >> 2) & 127, b = m >> 9; const int c = c0 > 126 ? 126 : c0; const int l = k >> 6, d = k & 63;
    return act + (size_t)(b * SEQ + 16 * c + l) * N1 + col0 + g * 64 + d; } };

template <class AF, class Epi>
__device__ __forceinline__ void gemm_simple(const AF& af, const bf16_t* Bt, int ldb, int M, int N, int K, float* lds, const Epi& epi) {
    float* As = lds;
    float* Bs = lds + 128 * 33;
    const int tid = threadIdx.x, r = tid & 127, cgp = tid >> 7;
    const int tilesN = N / 64, ntiles = (M / 128) * tilesN;
    for (int tile = blockIdx.x; tile < ntiles; tile += gridDim.x) {
        const int tm = tile / tilesN, tn = tile % tilesN;
        float acc[16];
#pragma unroll
        for (int j = 0; j < 16; ++j) acc[j] = 0.f;
        for (int k0 = 0; k0 < K; k0 += 32) {
            __syncthreads();
            { const int ar = tid >> 2, ak = (tid & 3) * 8; const uint4 v = *(const uint4*)af(tm * 128 + ar, k0 + ak); float* d = As + ar * 33 + ak;
              d[0] = lo_f(v.x); d[1] = hi_f(v.x); d[2] = lo_f(v.y); d[3] = hi_f(v.y); d[4] = lo_f(v.z); d[5] = hi_f(v.z); d[6] = lo_f(v.w); d[7] = hi_f(v.w); }
            if (tid < 256) { const int bn = tid >> 2, bk = (tid & 3) * 8; const uint4 v = *(const uint4*)(Bt + (size_t)(tn * 64 + bn) * ldb + k0 + bk); float* d = Bs + bk * 64 + bn;
              d[0] = lo_f(v.x); d[64] = hi_f(v.x); d[128] = lo_f(v.y); d[192] = hi_f(v.y); d[256] = lo_f(v.z); d[320] = hi_f(v.z); d[384] = lo_f(v.w); d[448] = hi_f(v.w); }
            __syncthreads();
#pragma unroll 4
            for (int kk = 0; kk < 32; ++kk) {
                const float a = As[r * 33 + kk]; const float* bp = Bs + kk * 64 + cgp * 16;
#pragma unroll
                for (int j = 0; j < 16; ++j) acc[j] += a * bp[j];
            }
        }
        epi(tm * 128 + r, tn * 64 + cgp * 16, acc);
    }
}

namespace att {
typedef short bf16x8 __attribute__((ext_vector_type(8)));
typedef short s16x4 __attribute__((ext_vector_type(4)));
typedef float f32x16 __attribute__((ext_vector_type(16)));
typedef float f32x4 __attribute__((ext_vector_type(4)));
typedef unsigned u32x4 __attribute__((ext_vector_type(4)));
#define ALDS __attribute__((address_space(3)))
constexpr int SLOTB = 8192, L_K = 0, L_V = 2 * SLOTB, L_CB = 4 * SLOTB, L_WS = L_CB + 8192, L_OST = L_WS + 2048, L_END = L_OST + 65536;
constexpr float LOG2E = 1.4426950408889634f, C2 = 0.125f * LOG2E;
constexpr float THR = 8.f, NEGBIG = -1e30f, MINIT = -200.f;

__device__ __forceinline__ int crow(int r, int hi) { return (r & 3) + 8 * (r >> 2) + 4 * hi; }
__device__ __forceinline__ void glds16(const void* gsrc, unsigned lds_dst) { unsigned keep;
    asm volatile("s_mov_b32 %0, m0\n\ts_mov_b32 m0, %2\n\ts_nop 0\n\tglobal_load_lds_dwordx4 %1, off\n\ts_mov_b32 m0, %0" : "=&s"(keep) : "v"(gsrc), "s"(lds_dst) : "memory"); }
typedef float f32x2_t __attribute__((ext_vector_type(2))); typedef __bf16 bf16x2_t __attribute__((ext_vector_type(2)));
__device__ __forceinline__ unsigned cvtpk(float lo, float hi) { f32x2_t v = {lo, hi}; bf16x2_t b = __builtin_convertvector(v, bf16x2_t); return __builtin_bit_cast(unsigned, b); }
typedef short v4i16_t __attribute__((ext_vector_type(4)));
__device__ __forceinline__ s16x4 vtr(const ALDS char* p) { return __builtin_bit_cast(s16x4, __builtin_amdgcn_ds_read_tr16_b64_v4i16((ALDS v4i16_t*)p)); }

__device__ __forceinline__ void stage_tile(const bf16_t* Kt, const bf16_t* Vt, int pitch, unsigned kdst, unsigned vdst, int wid, int lane) {
    glds16(Kt + (size_t)lane * pitch + wid * 8, (unsigned)__builtin_amdgcn_readfirstlane(kdst + wid * 1024));
    glds16(Vt + (size_t)(16 * (wid & 3) + (lane >> 2)) * pitch + (wid >> 2) * 32 + (lane & 3) * 8, (unsigned)__builtin_amdgcn_readfirstlane(vdst + wid * 1024));
}
__device__ __forceinline__ void qkt(f32x16& p0, f32x16& p1, const ALDS char* Kslot, const bf16x8 (&qr)[4], const f32x16& c0, const f32x16& c1, int r32, int hi) {
    const ALDS char* kb = Kslot + hi * 1024 + r32 * 16;
#pragma unroll
    for (int d0 = 0; d0 < 4; ++d0) {
        const bf16x8 b0 = *(const ALDS bf16x8*)(kb + d0 * 2048), b1 = *(const ALDS bf16x8*)(kb + d0 * 2048 + 512);
        if (d0 == 0) { p0 = __builtin_amdgcn_mfma_f32_32x32x16_bf16(b0, qr[0], c0, 0, 0, 0); p1 = __builtin_amdgcn_mfma_f32_32x32x16_bf16(b1, qr[0], c1, 0, 0, 0); }
        else { p0 = __builtin_amdgcn_mfma_f32_32x32x16_bf16(b0, qr[d0], p0, 0, 0, 0); p1 = __builtin_amdgcn_mfma_f32_32x32x16_bf16(b1, qr[d0], p1, 0, 0, 0); } }
}
__device__ __forceinline__ float rowmax(const f32x16& p0, const f32x16& p1) {
    float a = fmaxf(p0[0], p1[0]), b = fmaxf(p0[1], p1[1]);
#pragma unroll
    for (int r = 2; r < 16; r += 2) { a = fmaxf(a, fmaxf(p0[r], p1[r])); b = fmaxf(b, fmaxf(p0[r + 1], p1[r + 1])); }
    const float m = fmaxf(a, b);
    return fmaxf(m, __shfl_xor(m, 32));
}
__device__ __forceinline__ void softmax_pv(f32x16& p0, f32x16& p1, const ALDS char* Vl, f32x16 (&o)[2], float& mhat, float& lsum, volatile ALDS float* wsf, int r32, int hi) {
    const float rm = rowmax(p0, p1);
    if (__any(rm > THR)) {
        const float dl = fmaxf(rm, 0.f); mhat += dl;
#pragma unroll
        for (int r = 0; r < 16; ++r) { p0[r] -= dl; p1[r] -= dl; }
        const float f = __builtin_amdgcn_exp2f(-dl); lsum *= f;
        if (hi == 0) wsf[r32] = f;
        asm volatile("s_waitcnt lgkmcnt(0)" ::: "memory");
#pragma unroll
        for (int r = 0; r < 16; ++r) { const float fr = wsf[crow(r, hi)]; o[0][r] *= fr; o[1][r] *= fr; }
    }
    float s0 = 0.f, s1 = 0.f;
#pragma unroll
    for (int r = 0; r < 16; ++r) { p0[r] = __builtin_amdgcn_exp2f(p0[r]); p1[r] = __builtin_amdgcn_exp2f(p1[r]); s0 += p0[r]; s1 += p1[r]; }
    lsum += s0 + s1;
    u32x4 pw0, pw1, pw2, pw3;
    pw0 = (u32x4){cvtpk(p0[0], p0[1]), cvtpk(p0[2], p0[3]), cvtpk(p0[4], p0[5]), cvtpk(p0[6], p0[7])};
    pw1 = (u32x4){cvtpk(p0[8], p0[9]), cvtpk(p0[10], p0[11]), cvtpk(p0[12], p0[13]), cvtpk(p0[14], p0[15])};
    pw2 = (u32x4){cvtpk(p1[0], p1[1]), cvtpk(p1[2], p1[3]), cvtpk(p1[4], p1[5]), cvtpk(p1[6], p1[7])};
    pw3 = (u32x4){cvtpk(p1[8], p1[9]), cvtpk(p1[10], p1[11]), cvtpk(p1[12], p1[13]), cvtpk(p1[14], p1[15])};
    const bf16x8 pa[4] = {__builtin_bit_cast(bf16x8, pw0), __builtin_bit_cast(bf16x8, pw1), __builtin_bit_cast(bf16x8, pw2), __builtin_bit_cast(bf16x8, pw3)};
#pragma unroll
    for (int d0 = 0; d0 < 2; ++d0)
#pragma unroll
        for (int ks = 0; ks < 4; ++ks) { const s16x4 lo = vtr(Vl + d0 * 4096 + ks * 1024), hh = vtr(Vl + d0 * 4096 + ks * 1024 + 512);
            const bf16x8 vf = {lo[0], lo[1], lo[2], lo[3], hh[0], hh[1], hh[2], hh[3]};
            o[d0] = __builtin_amdgcn_mfma_f32_32x32x16_bf16(pa[ks], vf, o[d0], 0, 0, 0); }
}

__device__ __forceinline__ void fox_unit(int b, int h, int qb, const bf16_t* act, const float* cum, bf16_t* ao, unsigned char* lds_generic) {
    int tid_ = threadIdx.x; asm volatile("" : "+v"(tid_));
    const int tid = tid_, lane = tid & 63, r32 = lane & 31, hi = lane >> 5; const int wid = __builtin_amdgcn_readfirstlane(tid >> 6);
    ALDS char* lds = (ALDS char*)lds_generic; const unsigned lds0 = (unsigned)(uintptr_t)lds;
    ALDS float* CB = (ALDS float*)(lds + L_CB); volatile ALDS float* wsf = (volatile ALDS float*)(lds + L_WS) + wid * 64; ALDS float* ost = (ALDS float*)(lds + L_OST) + wid * 2048;
    const int q0 = qb * 256, bh = b * 16 + h; const size_t rowbase = (size_t)b * 2048; constexpr int P = 4096;
    for (int i = tid; i < q0 + 256; i += 512) CB[i] = cum[(size_t)bh * 2048 + i] * LOG2E;
    const bf16_t* Qw = act + (rowbase + q0 + wid * 32) * P + h * 64;
    bf16x8 qr[4];
#pragma unroll
    for (int d0 = 0; d0 < 4; ++d0) qr[d0] = *(const bf16x8*)(Qw + (size_t)r32 * P + d0 * 16 + hi * 8);
    const bf16_t* Kh = act + rowbase * P + 1024 + h * 64; const bf16_t* Vh = Kh + 1024;
    const int NT = 4 * (qb + 1);
    stage_tile(Kh + (size_t)(NT - 1) * 64 * P, Vh + (size_t)(NT - 1) * 64 * P, P, lds0 + L_K, lds0 + L_V, wid, lane);
    float mhat = MINIT, lsum = 0.f; f32x16 o[2];
#pragma unroll
    for (int r = 0; r < 16; ++r) { o[0][r] = 0.f; o[1][r] = 0.f; }
    const int qfirst = q0 + wid * 32, qabs = qfirst + r32;
    const int vlane = ((lane >> 4) & 1) * 32 + (lane & 3) * 8 + (4 * hi + ((lane & 15) >> 2)) * 64;
    for (int it = 0; it < NT; ++it) {
        const int j = NT - 1 - it, slot = it & 1;
        asm volatile("s_waitcnt vmcnt(0)" ::: "memory"); __syncthreads();
        if (it + 1 < NT) stage_tile(Kh + (size_t)(j - 1) * 64 * P, Vh + (size_t)(j - 1) * 64 * P, P, lds0 + L_K + (slot ^ 1) * SLOTB, lds0 + L_V + (slot ^ 1) * SLOTB, wid, lane);
        if (64 * j <= qfirst + 31) {
            const float cbq = CB[qabs]; const float qoff = cbq - mhat; const ALDS float* cbt = CB + 64 * j + 4 * hi;
            f32x16 c0, c1, p0, p1;
#pragma unroll
            for (int i = 0; i < 4; ++i) { const f32x4 a = *(const ALDS f32x4*)(cbt + 8 * i), bb = *(const ALDS f32x4*)(cbt + 32 + 8 * i);
#pragma unroll
                for (int e = 0; e < 4; ++e) { c0[4 * i + e] = qoff - a[e]; c1[4 * i + e] = qoff - bb[e]; } }
            qkt(p0, p1, lds + L_K + slot * SLOTB, qr, c0, c1, r32, hi);
            if (64 * j + 63 > qfirst) { const int qrel = qabs - 64 * j;
#pragma unroll
                for (int r = 0; r < 16; ++r) { const int kv = crow(r, hi); if (kv > qrel) p0[r] = NEGBIG; if (kv + 32 > qrel) p1[r] = NEGBIG; } }
            softmax_pv(p0, p1, lds + L_V + slot * SLOTB + vlane, o, mhat, lsum, wsf, r32, hi);
        }
    }
    lsum += __shfl_xor(lsum, 32);
    const float invl = lsum > 0.f ? 1.f / lsum : 0.f;
    if (hi == 0) wsf[32 + r32] = invl;
    asm volatile("s_waitcnt lgkmcnt(0)" ::: "memory");
#pragma unroll
    for (int r = 0; r < 16; ++r) { const int orow = crow(r, hi); const float il = wsf[32 + orow]; ost[orow * 64 + r32] = o[0][r] * il; ost[orow * 64 + 32 + r32] = o[1][r] * il; }
    asm volatile("s_waitcnt lgkmcnt(0)" ::: "memory");
#pragma unroll
    for (int i = 0; i < 4; ++i) { const int row = i * 8 + (lane >> 3), ch = lane & 7;
        const f32x4 a = *(const ALDS f32x4*)(ost + row * 64 + ch * 8), c = *(const ALDS f32x4*)(ost + row * 64 + ch * 8 + 4);
        const size_t grow = rowbase + qfirst + row; const uint4 zz = *(const uint4*)(act + grow * P + 3072 + h * 64 + ch * 8);
        const float z[8] = {lo_f(zz.x), hi_f(zz.x), lo_f(zz.y), hi_f(zz.y), lo_f(zz.z), hi_f(zz.z), lo_f(zz.w), hi_f(zz.w)};
        const float v[8] = {a[0], a[1], a[2], a[3], c[0], c[1], c[2], c[3]}; u32 w[4];
#pragma unroll
        for (int e = 0; e < 4; ++e) w[e] = cvtpk(v[2 * e] * z[2 * e] * sigmoidf_(z[2 * e]), v[2 * e + 1] * z[2 * e + 1] * sigmoidf_(z[2 * e + 1]));
        *(uint4*)(ao + grow * 1024 + h * 64 + ch * 8) = make_uint4(w[0], w[1], w[2], w[3]); }
    asm volatile("s_waitcnt lgkmcnt(0)" ::: "memory"); __syncthreads();
}
__device__ __forceinline__ void nsa_tile_src(int it, int ncmp, int cur, int b, int g, const bf16_t* act, const bf16_t* kc, const bf16_t* vc, const bf16_t*& K, const bf16_t*& V, int& pitch) {
    if (it < ncmp) { const size_t o = ((size_t)(b * 128 + 64 * it) * 4 + g) * 64; K = kc + o; V = vc + o; pitch = 256; }
    else { int j; int ck, cv; if (it < ncmp + cur + 1) { j = cur - (it - ncmp); ck = C1_KS; cv = C1_VS; } else { j = cur - (it - ncmp - cur - 1); ck = C1_KW; cv = C1_VW; }
        const size_t o = ((size_t)b * 2048 + 64 * j) * N1 + g * 64; K = act + o + ck; V = act + o + cv; pitch = N1; }
}
__device__ __forceinline__ void branch_finish(f32x16 (&oacc)[2], const f32x16 (&o)[2], float lsum, float gate, volatile ALDS float* wsf, int r32, int hi) {
    const float l = lsum + __shfl_xor(lsum, 32);
    const float fac = l > 0.f ? gate / l : 0.f;
    if (hi == 0) wsf[32 + r32] = fac;
    asm volatile("s_waitcnt lgkmcnt(0)" ::: "memory");
#pragma unroll
    for (int r = 0; r < 16; ++r) { const float f = wsf[32 + crow(r, hi)]; oacc[0][r] += o[0][r] * f; oacc[1][r] += o[1][r] * f; }
    asm volatile("s_waitcnt lgkmcnt(0)" ::: "memory");
}
#define NSA_STEP_BEGIN() do { asm volatile("s_waitcnt vmcnt(0)" ::: "memory"); __syncthreads(); \
    if (it + 1 < NTU) { const bf16_t* K_; const bf16_t* V_; int pt_; nsa_tile_src(it + 1, ncmp, cur, b, g, act, kc, vc, K_, V_, pt_); \
        stage_tile(K_, V_, pt_, lds0 + L_K + ((it + 1) & 1) * SLOTB, lds0 + L_V + ((it + 1) & 1) * SLOTB, wid, lane); } } while (0)
#define NSA_RESET() do { mhat = MINIT; lsum = 0.f; _Pragma("unroll") for (int r_ = 0; r_ < 16; ++r_) { o[0][r_] = 0.f; o[1][r_] = 0.f; } } while (0)

__device__ __forceinline__ void nsa_unit(int b, int g, int tb, const bf16_t* act, const bf16_t* kc, const bf16_t* vc, bf16_t* ao, unsigned char* lds_generic) {
    int tid_ = threadIdx.x; asm volatile("" : "+v"(tid_));
    const int tid = tid_, lane = tid & 63, r32 = lane & 31, hi = lane >> 5; const int wid = __builtin_amdgcn_readfirstlane(tid >> 6);
    ALDS char* lds = (ALDS char*)lds_generic; const unsigned lds0 = (unsigned)(uintptr_t)lds;
    volatile ALDS float* wsf = (volatile ALDS float*)(lds + L_WS) + wid * 64; ALDS float* ost = (ALDS float*)(lds + L_OST) + wid * 2048;
    const int cur = tb, t0 = 64 * tb; const size_t rowbase = (size_t)b * 2048;
    const int ti = r32 & 7, hr = r32 >> 3, trel = 8 * wid + ti, t = t0 + trel, h = 4 * g + hr;
    const bf16_t* prow = act + (rowbase + t) * N1;
    bf16x8 qr[4];
#pragma unroll
    for (int d0 = 0; d0 < 4; ++d0) qr[d0] = *(const bf16x8*)(prow + h * 64 + d0 * 16 + hi * 8);
    const float gate_c = sigmoidf_(bf2f(prow[C1_GATE + h * 3])), gate_s = sigmoidf_(bf2f(prow[C1_GATE + h * 3 + 1])), gate_w = sigmoidf_(bf2f(prow[C1_GATE + h * 3 + 2]));
    const int ncmp = tb >= 16 ? 2 : 1, jlo = cur > 8 ? cur - 8 : 0, NTU = ncmp + (cur + 1) + (cur - jlo + 1);
    const int vlane = ((lane >> 4) & 1) * 32 + (lane & 3) * 8 + (4 * hi + ((lane & 15) >> 2)) * 64;
    { const bf16_t* K_; const bf16_t* V_; int pt_; nsa_tile_src(0, ncmp, cur, b, g, act, kc, vc, K_, V_, pt_); stage_tile(K_, V_, pt_, lds0 + L_K, lds0 + L_V, wid, lane); }
    float mhat, lsum; f32x16 o[2], oacc[2];
#pragma unroll
    for (int r = 0; r < 16; ++r) { oacc[0][r] = 0.f; oacc[1][r] = 0.f; }
    int it = 0;
    unsigned mymask;
    {   NSA_RESET();
        const int cmax_t = t >= 31 ? ((t - 31) >> 4) : -1;
        f32x16 sA0, sA1, sB0, sB1, zc;
#pragma unroll
        for (int r = 0; r < 16; ++r) { zc[r] = 0.f; sB0[r] = NEGBIG; sB1[r] = NEGBIG; }
        {   NSA_STEP_BEGIN();
            qkt(sA0, sA1, lds + L_K + (it & 1) * SLOTB, qr, zc, zc, r32, hi);
#pragma unroll
            for (int r = 0; r < 16; ++r) { const int c = crow(r, hi); if (c > cmax_t) sA0[r] = NEGBIG; if (c + 32 > cmax_t) sA1[r] = NEGBIG; }
            f32x16 p0, p1;
#pragma unroll
            for (int r = 0; r < 16; ++r) { p0[r] = sA0[r] - mhat; p1[r] = sA1[r] - mhat; }
            softmax_pv(p0, p1, lds + L_V + (it & 1) * SLOTB + vlane, o, mhat, lsum, wsf, r32, hi); ++it; }
        if (ncmp == 2) { NSA_STEP_BEGIN();
            qkt(sB0, sB1, lds + L_K + (it & 1) * SLOTB, qr, zc, zc, r32, hi);
#pragma unroll
            for (int r = 0; r < 16; ++r) { const int c = 64 + crow(r, hi); if (c > cmax_t) sB0[r] = NEGBIG; if (c + 32 > cmax_t) sB1[r] = NEGBIG; }
            f32x16 p0, p1;
#pragma unroll
            for (int r = 0; r < 16; ++r) { p0[r] = sB0[r] - mhat; p1[r] = sB1[r] - mhat; }
            softmax_pv(p0, p1, lds + L_V + (it & 1) * SLOTB + vlane, o, mhat, lsum, wsf, r32, hi); ++it; }
        branch_finish(oacc, o, lsum, gate_c, wsf, r32, hi);
        ALDS float* PS = ost; ALDS float* IMP = ost + 1024; ALDS unsigned* BITS = (ALDS unsigned*)(ost + 1280);
        const float lt = lsum + __shfl_xor(lsum, 32); const float inv = lt > 0.f ? 1.f / lt : 0.f;
#pragma unroll
        for (int r = 0; r < 16; ++r) { const int c = crow(r, hi);
            float a0 = __builtin_amdgcn_exp2f(sA0[r] - mhat) * inv, a1 = __builtin_amdgcn_exp2f(sA1[r] - mhat) * inv;
            a0 += __shfl_xor(a0, 8); a0 += __shfl_xor(a0, 16); a1 += __shfl_xor(a1, 8); a1 += __shfl_xor(a1, 16);
            if (r32 < 8) { PS[ti * 128 + c] = a0; PS[ti * 128 + 32 + c] = a1; }
            if (ncmp == 2) { float b0 = __builtin_amdgcn_exp2f(sB0[r] - mhat) * inv, b1 = __builtin_amdgcn_exp2f(sB1[r] - mhat) * inv;
                b0 += __shfl_xor(b0, 8); b0 += __shfl_xor(b0, 16); b1 += __shfl_xor(b1, 8); b1 += __shfl_xor(b1, 16);
                if (r32 < 8) { PS[ti * 128 + 64 + c] = b0; PS[ti * 128 + 96 + c] = b1; } } }
        asm volatile("s_waitcnt lgkmcnt(0)" ::: "memory");
        const int ti2 = lane & 7, jg = lane >> 3; float val[4];
#pragma unroll
        for (int k = 0; k < 4; ++k) { const int j = 4 * jg + k; float imp = 0.f;
            if (j <= cur) {
#pragma unroll
                for (int e = -1; e <= 3; ++e) { const int c = 4 * j + e; if (c >= 0 && c < 127) imp += PS[ti2 * 128 + c]; } }
            const bool forced = (j == 0) || (j == cur) || (j == cur - 1);
            val[k] = forced ? 1e6f : (j <= cur ? imp : -1.f); IMP[ti2 * 32 + j] = val[k]; }
        asm volatile("s_waitcnt lgkmcnt(0)" ::: "memory");
        unsigned bits = 0u; int rank[4] = {0, 0, 0, 0};
#pragma unroll
        for (int q4 = 0; q4 < 8; ++q4) { const f32x4 vv = *(const ALDS f32x4*)(IMP + ti2 * 32 + 4 * q4);
#pragma unroll
            for (int e = 0; e < 4; ++e) { const int jj = 4 * q4 + e; const float vj = vv[e];
#pragma unroll
                for (int k = 0; k < 4; ++k) { const int j = 4 * jg + k; rank[k] += ((vj > val[k]) || (vj == val[k] && jj < j)) ? 1 : 0; } } }
#pragma unroll
        for (int k = 0; k < 4; ++k) if (rank[k] < 8) bits |= 1u << (4 * jg + k);
        BITS[ti2 * 8 + jg] = bits;
        asm volatile("s_waitcnt lgkmcnt(0)" ::: "memory");
        mymask = 0u;
#pragma unroll
        for (int q8 = 0; q8 < 8; ++q8) mymask |= BITS[ti * 8 + q8];
        asm volatile("s_waitcnt lgkmcnt(0)" ::: "memory");
    }
    NSA_RESET();
    for (int j = cur; j >= 0; --j) { NSA_STEP_BEGIN();
        const bool mine = (mymask >> j) & 1u;
        if (__any(mine)) {
            f32x16 cm, p0, p1; const float nm = -mhat;
#pragma unroll
            for (int r = 0; r < 16; ++r) cm[r] = nm;
            qkt(p0, p1, lds + L_K + (it & 1) * SLOTB, qr, cm, cm, r32, hi);
            if (j == cur) {
#pragma unroll
                for (int r = 0; r < 16; ++r) { const int kv = crow(r, hi); if (kv > trel) p0[r] = NEGBIG; if (kv + 32 > trel) p1[r] = NEGBIG; } }
            if (!mine) {
#pragma unroll
                for (int r = 0; r < 16; ++r) { p0[r] = NEGBIG; p1[r] = NEGBIG; } }
            softmax_pv(p0, p1, lds + L_V + (it & 1) * SLOTB + vlane, o, mhat, lsum, wsf, r32, hi); }
        ++it; }
    branch_finish(oacc, o, lsum, gate_s, wsf, r32, hi);
    NSA_RESET();
    for (int j = cur; j >= jlo; --j) { NSA_STEP_BEGIN();
        f32x16 cm, p0, p1; const float nm = -mhat;
#pragma unroll
        for (int r = 0; r < 16; ++r) cm[r] = nm;
        qkt(p0, p1, lds + L_K + (it & 1) * SLOTB, qr, cm, cm, r32, hi);
        if (j == cur) {
#pragma unroll
            for (int r = 0; r < 16; ++r) { const int kv = crow(r, hi); if (kv > trel) p0[r] = NEGBIG; if (kv + 32 > trel) p1[r] = NEGBIG; } }
        if (j == cur - 8) {
#pragma unroll
            for (int r = 0; r < 16; ++r) { const int kv = crow(r, hi); if (kv <= trel) p0[r] = NEGBIG; if (kv + 32 <= trel) p1[r] = NEGBIG; } }
        softmax_pv(p0, p1, lds + L_V + (it & 1) * SLOTB + vlane, o, mhat, lsum, wsf, r32, hi);
        ++it; }
    branch_finish(oacc, o, lsum, gate_w, wsf, r32, hi);
#pragma unroll
    for (int r = 0; r < 16; ++r) { const int orow = crow(r, hi); ost[orow * 64 + r32] = oacc[0][r]; ost[orow * 64 + 32 + r32] = oacc[1][r]; }
    asm volatile("s_waitcnt lgkmcnt(0)" ::: "memory");
#pragma unroll
    for (int i = 0; i < 4; ++i) { const int row = i * 8 + (lane >> 3), ch = lane & 7; const int tok = t0 + 8 * wid + (row & 7), hh = 4 * g + (row >> 3);
        const f32x4 a = *(const ALDS f32x4*)(ost + row * 64 + ch * 8), c = *(const ALDS f32x4*)(ost + row * 64 + ch * 8 + 4);
        const size_t grow = rowbase + tok; const uint4 zz = *(const uint4*)(act + grow * N1 + C1_Z + hh * 64 + ch * 8);
        const float z[8] = {lo_f(zz.x), hi_f(zz.x), lo_f(zz.y), hi_f(zz.y), lo_f(zz.z), hi_f(zz.z), lo_f(zz.w), hi_f(zz.w)};
        const float v[8] = {a[0], a[1], a[2], a[3], c[0], c[1], c[2], c[3]}; u32 w[4];
#pragma unroll
        for (int e = 0; e < 4; ++e) w[e] = cvtpk(v[2 * e] * z[2 * e] * sigmoidf_(z[2 * e]), v[2 * e + 1] * z[2 * e + 1] * sigmoidf_(z[2 * e + 1]));
        *(uint4*)(ao + grow * 1024 + hh * 64 + ch * 8) = make_uint4(w[0], w[1], w[2], w[3]); }
    asm volatile("s_waitcnt lgkmcnt(0)" ::: "memory"); __syncthreads();
}
#undef NSA_STEP_BEGIN
#undef NSA_RESET
}

__global__ void __launch_bounds__(512) fwd_kernel(Params p) {
    extern __shared__ __attribute__((aligned(16))) unsigned char lds_raw[];
    float* ldsf = (float*)lds_raw; pg8::PG8_LAS_T ldsL = (pg8::PG8_LAS_T)lds_raw;
    cg::grid_group grid = cg::this_grid();
    const int tid = threadIdx.x, lane = tid & 63, wib = tid >> 6;
    const int gtid = blockIdx.x * 512 + tid, gsz = gridDim.x * 512;
    const int gwave = blockIdx.x * 8 + wib, nwaves = gridDim.x * 8;

    const float* x = p.in[0]; const float* norm_g = p.in[1]; const float* fox_w_in = p.in[2]; const float* fox_b_f = p.in[3]; const float* fox_w_out = p.in[4];
    const float* nsa_w_in = p.in[5]; const float* pe_k = p.in[6]; const float* w_ck1 = p.in[7]; const float* w_ck2 = p.in[8];
    const float* pe_v = p.in[9]; const float* w_cv1 = p.in[10]; const float* w_cv2 = p.in[11]; const float* nsa_w_out = p.in[12]; const float* final_g = p.in[13];
    float* out = p.out; unsigned char* ws = p.ws;
    bf16_t* W0T = (bf16_t*)(ws + WS_W0T); bf16_t* WO0T = (bf16_t*)(ws + WS_WO0T); bf16_t* W1T = (bf16_t*)(ws + WS_W1T); bf16_t* WO1T = (bf16_t*)(ws + WS_WO1T);
    bf16_t* WCK1T = (bf16_t*)(ws + WS_WCK1T); bf16_t* WCV1T = (bf16_t*)(ws + WS_WCV1T); bf16_t* WCK2T = (bf16_t*)(ws + WS_WCK2T); bf16_t* WCV2T = (bf16_t*)(ws + WS_WCV2T);
    float* CBIAS = (float*)(ws + WS_CBIAS); float* ROPE = (float*)(ws + WS_ROPE); float* RS0 = (float*)(ws + WS_RS0); float* RS1 = (float*)(ws + WS_RS1);
    float* LOGF = (float*)(ws + WS_LOGF); float* CUM = (float*)(ws + WS_CUM);
    bf16_t* KC = (bf16_t*)(ws + WS_KC); bf16_t* VC = (bf16_t*)(ws + WS_VC); bf16_t* HID = (bf16_t*)(ws + WS_HID);
    bf16_t* XB = (bf16_t*)(ws + WS_XB); bf16_t* ACT = (bf16_t*)(ws + WS_ACT); bf16_t* AO = (bf16_t*)(ws + WS_AO);
    const float* g0 = norm_g; const float* g1 = norm_g + DM;

    for (int i = gtid; i < N0 * DM; i += gsz) { const int k = i / N0, n = i % N0; const int col = n < 3072 ? n : n + 16; W0T[(size_t)n * DM + k] = f2bf(g0[k] * fox_w_in[(size_t)k * FOX_IN + col]); }
    for (int i = gtid; i < N1 * DM; i += gsz) { const int k = i / N1, n = i % N1; float v = 0.f;
        if (n < C1_Z) v = nsa_w_in[(size_t)k * NSA_IN + n]; else if (n < C1_GATE) v = nsa_w_in[(size_t)k * NSA_IN + n + 48]; else if (n < C1_GATE + 48) v = nsa_w_in[(size_t)k * NSA_IN + n - 1024];
        W1T[(size_t)n * DM + k] = f2bf(g1[k] * v); }
    for (int i = gtid; i < DM * DM; i += gsz) { const int k = i / DM, n = i % DM; WO0T[(size_t)n * DM + k] = f2bf(fox_w_out[i]); WO1T[(size_t)n * DM + k] = f2bf(nsa_w_out[i]); }
    for (int i = gtid; i < 2048 * 256; i += gsz) { const int k = i / 256, n = i % 256; WCK1T[(size_t)n * 2048 + k] = f2bf(w_ck1[i]); WCV1T[(size_t)n * 2048 + k] = f2bf(w_cv1[i]); }
    for (int i = gtid; i < 256 * 64; i += gsz) { const int k = i / 64, n = i % 64; WCK2T[n * 256 + k] = f2bf(w_ck2[i]); WCV2T[n * 256 + k] = f2bf(w_cv2[i]); }
    for (int i = gtid; i < SEQ * 8; i += gsz) { const int pos = i >> 3, j = i & 7; const double inv = pow(500000.0, -(double)j / 8.0); const double a = (double)pos * inv;
        ROPE[pos * 16 + j] = (float)cos(a); ROPE[pos * 16 + 8 + j] = (float)sin(a); }
    for (int o = gwave; o < 512; o += nwaves) { const int kv = o >> 8, n = o & 255; const float* pe = kv ? pe_v : pe_k; const float* w1 = kv ? w_cv1 : w_ck1; float s = 0.f;
        for (int k = lane; k < 2048; k += 64) s += pe[k] * w1[(size_t)k * 256 + n];
        s = wave_sum(s); if (lane == 0) CBIAS[o] = s; }
    for (int row = gwave; row < MTOK; row += nwaves) {
        const float* xr = x + (size_t)row * DM; float4 v[4]; float ss = 0.f;
#pragma unroll
        for (int j = 0; j < 4; ++j) { v[j] = *(const float4*)(xr + j * 256 + lane * 4); ss += v[j].x * v[j].x + v[j].y * v[j].y + v[j].z * v[j].z + v[j].w * v[j].w; }
        ss = wave_sum(ss); const float rstd = rsqrtf(ss * (1.f / DM) + EPS);
        if (lane == 0) RS0[row] = rstd;
#pragma unroll
        for (int j = 0; j < 4; ++j) { uint2 w; w.x = (u32)f2bf(v[j].x) | ((u32)f2bf(v[j].y) << 16); w.y = (u32)f2bf(v[j].z) | ((u32)f2bf(v[j].w) << 16); *(uint2*)(XB + (size_t)row * DM + j * 256 + lane * 4) = w; }
        for (int h = 0; h < NH; ++h) { float s = 0.f;
#pragma unroll
            for (int j = 0; j < 4; ++j) { const int k = j * 256 + lane * 4; const float4 gg = *(const float4*)(g0 + k);
                s += v[j].x * gg.x * fox_w_in[(size_t)(k + 0) * FOX_IN + 3072 + h]; s += v[j].y * gg.y * fox_w_in[(size_t)(k + 1) * FOX_IN + 3072 + h];
                s += v[j].z * gg.z * fox_w_in[(size_t)(k + 2) * FOX_IN + 3072 + h]; s += v[j].w * gg.w * fox_w_in[(size_t)(k + 3) * FOX_IN + 3072 + h]; }
            s = wave_sum(s); const float f = s * rstd + fox_b_f[h];
            if (lane == 0) LOGF[row * 16 + h] = fminf(f, 0.f) - log1pf(expf(-fabsf(f))); }
    }
    grid.sync();

    { pg8::Gemm g{XB, W0T, MTOK, N0, DM}; pg8::StaticOrder S; S.init(MTOK, N0, (int)gridDim.x, (int)blockIdx.x);
      pg8::EpiProj E{ACT, N0, RS0, ROPE, 0u, 0xFu, att::C2};
      pg8::gemm_phase<pg8::EpiProj, pg8::StaticOrder, true, true>(ldsL, g, S, E); }
    for (int bh = gwave; bh < BATCH * NH; bh += nwaves) { const int b = bh >> 4, h = bh & 15; float loc = 0.f;
        for (int i = 0; i < 32; ++i) loc += LOGF[(size_t)(b * SEQ + lane * 32 + i) * 16 + h];
        float inc = loc;
#pragma unroll
        for (int o = 1; o < 64; o <<= 1) { const float t = __shfl_up(inc, o); if (lane >= o) inc += t; }
        float run = inc - loc;
        for (int i = 0; i < 32; ++i) { run += LOGF[(size_t)(b * SEQ + lane * 32 + i) * 16 + h]; CUM[(size_t)bh * SEQ + lane * 32 + i] = run; } }
    grid.sync();

    { const int G = (int)gridDim.x; const int vcu = (G % 8 == 0) ? ((int)blockIdx.x % 8) * (G / 8) + (int)blockIdx.x / 8 : (int)blockIdx.x;
      for (int gi = vcu; gi < 256; gi += G) { const int bh = gi >> 1, half = gi & 1;
          for (int i = 0; i < 4; ++i) { const int qb = half ? (i == 0 ? 2 : i == 1 ? 5 : i == 2 ? 3 : 4) : (i == 0 ? 0 : i == 1 ? 7 : i == 2 ? 1 : 6);
              att::fox_unit(bh >> 4, bh & 15, qb, ACT, CUM, AO, lds_raw); } } }
    grid.sync();

    { pg8::Gemm g{AO, WO0T, MTOK, DM, DM}; pg8::StaticOrder S; S.init(MTOK, DM, (int)gridDim.x, (int)blockIdx.x);
      pg8::EpiResid E{x, out, XB, DM};
      pg8::gemm_phase<pg8::EpiResid, pg8::StaticOrder, true, true>(ldsL, g, S, E); }
    grid.sync();
    for (int row = gwave; row < MTOK; row += nwaves) { const float* xr = out + (size_t)row * DM; float ss = 0.f;
#pragma unroll
        for (int j = 0; j < 4; ++j) { const float4 v = *(const float4*)(xr + j * 256 + lane * 4); ss += v.x * v.x + v.y * v.y + v.z * v.z + v.w * v.w; }
        ss = wave_sum(ss); if (lane == 0) RS1[row] = rsqrtf(ss * (1.f / DM) + EPS); }
    grid.sync();

    { pg8::Gemm g{XB, W1T, MTOK, N1, DM}; pg8::StaticOrder S; S.init(MTOK, N1, (int)gridDim.x, (int)blockIdx.x);
      pg8::EpiProj E{ACT, N1, RS1, ROPE, 0x14Fu, 0xFu, att::C2};
      pg8::gemm_phase<pg8::EpiProj, pg8::StaticOrder, true, true>(ldsL, g, S, E); }
    grid.sync();

    for (int kv = 0; kv < 2; ++kv) { ACmp af{ACT, kv ? C1_VC : C1_KC}; const float* cb = CBIAS + kv * 256; bf16_t* hid = HID + (size_t)kv * 4096 * 256;
      auto epi = [&](int row, int col0, const float (&acc)[16]) { u32 w[8];
#pragma unroll
          for (int j = 0; j < 8; ++j) { const float a0 = acc[2 * j] + cb[col0 + 2 * j], a1 = acc[2 * j + 1] + cb[col0 + 2 * j + 1]; w[j] = (u32)f2bf(a0 * sigmoidf_(a0)) | ((u32)f2bf(a1 * sigmoidf_(a1)) << 16); }
          uint4* d = (uint4*)(hid + (size_t)row * 256 + col0); d[0] = make_uint4(w[0], w[1], w[2], w[3]); d[1] = make_uint4(w[4], w[5], w[6], w[7]); };
      gemm_simple(af, kv ? WCV1T : WCK1T, 2048, 4096, 256, 2048, ldsf, epi); }
    grid.sync();
    for (int kv = 0; kv < 2; ++kv) { APlain af{HID + (size_t)kv * 4096 * 256, 256}; bf16_t* dst = kv ? VC : KC;
      auto epi = [&](int row, int col0, const float (&acc)[16]) { float v[16];
#pragma unroll
          for (int j = 0; j < 16; ++j) v[j] = acc[j];
          const int c = (row >> 2) & 127;
          if (kv == 0 && col0 == 0 && c < NCMP) { const float* rp = ROPE + (16 * c + 31) * 16;
#pragma unroll
              for (int i = 0; i < 8; ++i) { const float cc = rp[i], s = rp[8 + i], x1 = v[i], x2 = v[i + 8]; v[i] = x1 * cc - x2 * s; v[i + 8] = x1 * s + x2 * cc; } }
          u32 w[8];
#pragma unroll
          for (int j = 0; j < 8; ++j) w[j] = (u32)f2bf(v[2 * j]) | ((u32)f2bf(v[2 * j + 1]) << 16);
          uint4* d = (uint4*)(dst + (size_t)row * 64 + col0); d[0] = make_uint4(w[0], w[1], w[2], w[3]); d[1] = make_uint4(w[4], w[5], w[6], w[7]); };
      gemm_simple(af, kv ? WCV2T : WCK2T, 256, 4096, 64, 256, ldsf, epi); }
    grid.sync();

    { const int G = (int)gridDim.x; const int vcu = (G % 8 == 0) ? ((int)blockIdx.x % 8) * (G / 8) + (int)blockIdx.x / 8 : (int)blockIdx.x;
      for (int gi = vcu; gi < 256; gi += G) { const int bg = gi >> 3, pp = gi & 7;
          for (int i = 0; i < 4; ++i) { const int tb = i == 0 ? 31 - pp : i == 1 ? 16 + pp : i == 2 ? 15 - pp : pp;
              att::nsa_unit(bg >> 2, bg & 3, tb, ACT, KC, VC, AO, lds_raw); } } }
    grid.sync();

    { pg8::Gemm g{AO, WO1T, MTOK, DM, DM}; pg8::StaticOrder S; S.init(MTOK, DM, (int)gridDim.x, (int)blockIdx.x);
      pg8::EpiResid E{out, out, nullptr, DM};
      pg8::gemm_phase<pg8::EpiResid, pg8::StaticOrder, true, true>(ldsL, g, S, E); }
    grid.sync();
    for (int row = gwave; row < MTOK; row += nwaves) { float* xr = out + (size_t)row * DM; float4 v[4]; float ss = 0.f;
#pragma unroll
        for (int j = 0; j < 4; ++j) { v[j] = *(const float4*)(xr + j * 256 + lane * 4); ss += v[j].x * v[j].x + v[j].y * v[j].y + v[j].z * v[j].z + v[j].w * v[j].w; }
        ss = wave_sum(ss); const float rstd = rsqrtf(ss * (1.f / DM) + EPS);
#pragma unroll
        for (int j = 0; j < 4; ++j) { const float4 gg = *(const float4*)(final_g + j * 256 + lane * 4); float4 o; o.x = v[j].x * rstd * gg.x; o.y = v[j].y * rstd * gg.y; o.z = v[j].z * rstd * gg.z; o.w = v[j].w * rstd * gg.w; *(float4*)(xr + j * 256 + lane * 4) = o; } }
}

extern "C" void kernel_launch(void* const* d_in, const int* in_sizes, int n_in, void* d_out, int out_size, void* d_ws, size_t ws_size, hipStream_t stream) {
    constexpr size_t kDynLds = 147456;
    static int grid_blocks = 0;
    if (!grid_blocks) {
        int dev = 0, cus = 0, per_cu = 0;
        hipGetDevice(&dev);
        hipDeviceGetAttribute(&cus, hipDeviceAttributeMultiprocessorCount, dev);
        hipFuncSetAttribute((const void*)fwd_kernel, hipFuncAttributeMaxDynamicSharedMemorySize, (int)kDynLds);
        hipOccupancyMaxActiveBlocksPerMultiprocessor(&per_cu, (const void*)fwd_kernel, 512, kDynLds);
        if (per_cu < 1) per_cu = 1;
        if (per_cu > 1) per_cu = 1;
        grid_blocks = cus * per_cu;
        if (n_in != 14 || ws_size < WS_END) fprintf(stderr, "kernel_launch: unexpected n_in %d / ws_size %zu\n", n_in, ws_size);
    }
    Params p{};
    for (int i = 0; i < 14; ++i) p.in[i] = (const float*)d_in[i];
    p.out = (float*)d_out; p.ws = (unsigned char*)d_ws;
    void* args[] = {&p};
    hipError_t e = hipLaunchCooperativeKernel((const void*)fwd_kernel, dim3(grid_blocks), dim3(512), args, kDynLds, stream);
    if (e != hipSuccess) fprintf(stderr, "cooperative launch failed: %s (grid %d)\n", hipGetErrorString(e), grid_blocks);
}
```

```cpp
#include <hip/hip_runtime.h>
#include <hip/hip_cooperative_groups.h>
#include <cstdio>
#include <cstdint>
namespace cg = cooperative_groups;

typedef unsigned short bf16_t;
typedef unsigned int u32;

constexpr int DM = 1024, BATCH = 8, SEQ = 2048, MTOK = BATCH * SEQ;
constexpr int NH = 16, HD = 64;
constexpr int FOX_IN = 4 * DM + NH;
constexpr int NSA_IN = 3632;
constexpr int N0 = 4096;
constexpr int N1 = 3840;
constexpr int C1_Q = 0, C1_KC = 1024, C1_VC = 1280, C1_KS = 1536, C1_VS = 1792, C1_KW = 2048, C1_VW = 2304, C1_Z = 2560, C1_GATE = 3584;
constexpr int NCMP = 127, NCMP_P = 128;
constexpr float EPS = 1e-6f;

constexpr size_t MiB = 1u << 20;
constexpr size_t WS_CTL = 0;
constexpr size_t WS_W0T = 1 * MiB;
constexpr size_t WS_WO0T = 9 * MiB;
constexpr size_t WS_W1T = 11 * MiB;
constexpr size_t WS_WO1T = 19 * MiB;
constexpr size_t WS_WCK1T = 21 * MiB;
constexpr size_t WS_WCV1T = 22 * MiB;
constexpr size_t WS_WCK2T = 23 * MiB;
constexpr size_t WS_WCV2T = 23 * MiB + 65536;
constexpr size_t WS_CBIAS = 23 * MiB + 131072;
constexpr size_t WS_ROPE = 23 * MiB + 196608;
constexpr size_t WS_RS0 = 24 * MiB;
constexpr size_t WS_RS1 = 24 * MiB + 65536;
constexpr size_t WS_LOGF = 25 * MiB;
constexpr size_t WS_CUM = 26 * MiB;
constexpr size_t WS_KC = 27 * MiB;
constexpr size_t WS_VC = 27 * MiB + 524288;
constexpr size_t WS_HID = 28 * MiB;
constexpr size_t WS_XB = 32 * MiB;
constexpr size_t WS_ACT = 64 * MiB;
constexpr size_t WS_AO = 192 * MiB;
constexpr size_t WS_END = 224 * MiB;

struct Params { const float* in[14]; float* out; unsigned char* ws; };

__device__ __forceinline__ float bf2f(bf16_t v) { return __uint_as_float((u32)v << 16); }
__device__ __forceinline__ bf16_t f2bf(float f) { u32 u = __float_as_uint(f); return (bf16_t)((u + 0x7fffu + ((u >> 16) & 1u)) >> 16); }
__device__ __forceinline__ float lo_f(u32 w) { return __uint_as_float(w << 16); }
__device__ __forceinline__ float hi_f(u32 w) { return __uint_as_float(w & 0xffff0000u); }
__device__ __forceinline__ float wave_sum(float v) {
#pragma unroll
    for (int o = 1; o < 64; o <<= 1) v += __shfl_xor(v, o);
    return v;
}
__device__ __forceinline__ float wave_max(float v) {
#pragma unroll
    for (int o = 1; o < 64; o <<= 1) v = fmaxf(v, __shfl_xor(v, o));
    return v;
}
__device__ __forceinline__ float sigmoidf_(float x) { return 1.f / (1.f + __expf(-x)); }
__device__ __forceinline__ float dot64(const bf16_t* qu, const bf16_t* kp) {
    float s = 0.f;
#pragma unroll
    for (int i = 0; i < 8; ++i) {
        const uint4 a = ((const uint4*)qu)[i], b = ((const uint4*)kp)[i];
        s += lo_f(a.x) * lo_f(b.x); s += hi_f(a.x) * hi_f(b.x);
        s += lo_f(a.y) * lo_f(b.y); s += hi_f(a.y) * hi_f(b.y);
        s += lo_f(a.z) * lo_f(b.z); s += hi_f(a.z) * hi_f(b.z);
        s += lo_f(a.w) * lo_f(b.w); s += hi_f(a.w) * hi_f(b.w);
    }
    return s;
}

namespace pg8 {
#define PG8_LAS __attribute__((address_space(3)))
typedef PG8_LAS unsigned char* PG8_LAS_T;
typedef unsigned short bf16_t;
typedef short bf16x8 __attribute__((ext_vector_type(8)));
typedef float f32x4 __attribute__((ext_vector_type(4)));
typedef unsigned u32x4 __attribute__((ext_vector_type(4)));
constexpr int BM = 256, BK = 64, HALF = 128, HTB = HALF * BK * 2  , STAGE_BYTES = 8 * HTB, NXCD = 8, WGM = 8;

__host__ __device__ __forceinline__ int lds_byte(int r, int c) { const int st = (r >> 4) * 2 + (c >> 5), rr = r & 15, cc = c & 31, ob = rr * 64 + cc * 2; return st * 1024 + (ob ^ (((ob >> 9) & 1) << 5)); }
__host__ __device__ __forceinline__ void stage_rc(int b, int& R, int& C) { const int st = b / 1024, sb = b % 1024, swz = sb ^ (((sb >> 9) & 1) << 5); R = (st >> 1) * 16 + swz / 64; C = (st & 1) * 32 + (swz % 64) / 2; }
__host__ __device__ __forceinline__ int perm32(int rho) { const int n = rho >> 4, i = rho & 15; return 8 * (i >> 2) + 4 * n + (i & 3); }

struct Unit { int pm, pn; };
struct Gemm { const bf16_t* A; const bf16_t* Bt; int M, N, K; };

struct StaticOrder {
    int nM, nN, nwg, G, c;
    __host__ __device__ void init(int M, int N, int G_, int c_) { nM = M / BM; nN = N / BM; nwg = nM * nN; G = G_; c = c_; }
    __host__ __device__ bool next(int i, Unit& u) const {
        const long L = (long)i * G + c; if (L >= nwg) return false;
        int wgid = (int)L; { const int q = nwg / NXCD, r = nwg % NXCD, xcd = wgid % NXCD, off = wgid / NXCD; wgid = (xcd < r ? xcd * (q + 1) : r * (q + 1) + (xcd - r) * q) + off; }
        const int nig = WGM * nN, gid = wgid / nig, fm = gid * WGM, gsz = (nM - fm) < WGM ? (nM - fm) : WGM;
        u.pm = fm + ((wgid % nig) % gsz); u.pn = (wgid % nig) / gsz; return true;
    }
    __device__ __forceinline__ void a_ready(const Unit&) const {}
    __device__ __forceinline__ void done(const Unit&) const {}
};

__device__ __forceinline__ unsigned cvt_pk_bf16(float lo, float hi) { unsigned r; asm volatile("v_cvt_pk_bf16_f32 %0, %1, %2" : "=v"(r) : "v"(lo), "v"(hi)); return r; }
typedef float f32x2 __attribute__((ext_vector_type(2)));
__device__ __forceinline__ f32x2 gelu_pk(f32x2 v) {
    const f32x2 av = __builtin_elementwise_abs(v), d = av * 0.2316418882f + 1.0f;
    f32x2 t; t.x = __builtin_amdgcn_rcpf(d.x); t.y = __builtin_amdgcn_rcpf(d.y);
    f32x2 q = t * 0.5307027145f + (-0.7265760135f); q = q * t + 0.7107068705f; q = q * t + (-0.142248368f); q = q * t + 0.127414796f; q = q * t;
    const f32x2 s = (v * v) * (-0.72134752044f);
    f32x2 e; e.x = __builtin_amdgcn_exp2f(s.x); e.y = __builtin_amdgcn_exp2f(s.y);
    const f32x2 m = v * (q * e), r = v - m;
    f32x2 o; o.x = v.x < 0.f ? m.x : r.x; o.y = v.y < 0.f ? m.y : r.y; return o;
}

template <int ACT  > struct EpiBf16 {
    static constexpr bool PERM = true, AFTER_DRAIN = false; static_assert(ACT == 0 || ACT == 1, "EpiBf16: ACT is 0 (none) or 1 (gelu_pk)");
    bf16_t* O; int ldc; const float* bias; int split_cols; size_t split_stride; float scale0;
    __device__ __forceinline__ void operator()(const f32x4 (&acc)[2][2][4][2], const Unit& u, int wr, int wc, int fr, int fq) const {
        const int row0 = u.pm * BM + wr * 64 + fr; int colt = u.pn * BM; bf16_t* base = O;
        float sc = 1.f; if (split_cols) { const int t = colt / split_cols; base += (size_t)t * split_stride; colt -= t * split_cols; if (t == 0) sc = scale0; }
        const int col0 = colt + wc * 32 + 8 * fq, bcol0 = u.pn * BM + wc * 32 + 8 * fq;
        f32x4 bv[2][2];
#pragma unroll
        for (int bj = 0; bj < 2; ++bj)
#pragma unroll
            for (int n = 0; n < 2; ++n) bv[bj][n] = bias ? *(const f32x4*)(bias + bcol0 + bj * HALF + 4 * n) : (f32x4){0.f, 0.f, 0.f, 0.f};
#pragma unroll
        for (int ai = 0; ai < 2; ++ai)
#pragma unroll
            for (int m = 0; m < 4; ++m) { bf16_t* rowp = base + (size_t)(row0 + ai * HALF + m * 16) * ldc + col0;
#pragma unroll
                for (int bj = 0; bj < 2; ++bj) { f32x4 v0 = acc[ai][bj][m][0] + bv[bj][0], v1 = acc[ai][bj][m][1] + bv[bj][1];
                    if (ACT == 1) { f32x2 a = gelu_pk((f32x2){v0[0], v0[1]}), b = gelu_pk((f32x2){v0[2], v0[3]}), c = gelu_pk((f32x2){v1[0], v1[1]}), d = gelu_pk((f32x2){v1[2], v1[3]});
                        v0 = (f32x4){a.x, a.y, b.x, b.y}; v1 = (f32x4){c.x, c.y, d.x, d.y}; }
                    v0 = v0 * sc; v1 = v1 * sc; u32x4 w; w.x = cvt_pk_bf16(v0[0], v0[1]); w.y = cvt_pk_bf16(v0[2], v0[3]); w.z = cvt_pk_bf16(v1[0], v1[1]); w.w = cvt_pk_bf16(v1[2], v1[3]);
                    *(u32x4*)(rowp + bj * HALF) = w; } }
    }
};

struct PanelStats {
    unsigned* xbuf;
    unsigned* cnt;
    unsigned* tmo;
    int ntn; float eps;
    unsigned code;
    __device__ __forceinline__ bool run(const f32x4 (&v)[2][2][4][2], const Unit& u, int wr, int wc, int fr, int fq, PG8_LAS unsigned char* lds, int wid, int lane) const {
        typedef float f32x2v __attribute__((ext_vector_type(2)));
        PG8_LAS f32x2v* P = (PG8_LAS f32x2v*)lds;
        PG8_LAS f32x2v* S = (PG8_LAS f32x2v*)(lds + 8192);
        PG8_LAS unsigned* flag = (PG8_LAS unsigned*)(lds + 8192 + 2048);
#pragma unroll
        for (int ai = 0; ai < 2; ++ai)
#pragma unroll
            for (int m = 0; m < 4; ++m) {
                float s = 0.f;
#pragma unroll
                for (int bj = 0; bj < 2; ++bj)
#pragma unroll
                    for (int n = 0; n < 2; ++n) { const f32x4 x = v[ai][bj][m][n]; s += (x[0] + x[1]) + (x[2] + x[3]); }
                s += __shfl_xor(s, 16); s += __shfl_xor(s, 32);
                const float mw = s * (1.0f / 64.0f); float q = 0.f;
#pragma unroll
                for (int bj = 0; bj < 2; ++bj)
#pragma unroll
                    for (int n = 0; n < 2; ++n) { const f32x4 d = v[ai][bj][m][n] - mw; q += (d[0] * d[0] + d[1] * d[1]) + (d[2] * d[2] + d[3] * d[3]); }
                q += __shfl_xor(q, 16); q += __shfl_xor(q, 32);
                if (fq == 0) P[(ai * HALF + wr * 64 + m * 16 + fr) * 4 + wc] = (f32x2v){mw, q};
            }
        asm volatile("s_waitcnt lgkmcnt(0)" ::: "memory"); __builtin_amdgcn_s_barrier(); asm volatile("" ::: "memory");
#if defined(BROKEN_EXCHANGE_NO_WAIT)
#warning BROKEN CONTROL BUILD: the row-statistics exchange does not wait; results are wrong by design
        if (blockIdx.x >= 64) { const long long t0_ = clock64(); while (clock64() - t0_ < 60000) __builtin_amdgcn_s_sleep(8); }
#endif
        const int row = wid * 32 + (lane & 31);
        if (lane < 32) {
            const f32x2v a = P[row * 4 + 0], b = P[row * 4 + 1], c = P[row * 4 + 2], d = P[row * 4 + 3];
            const float mt = (a.x + b.x + c.x + d.x) * 0.25f;
            const float da = a.x - mt, db = b.x - mt, dc = c.x - mt, dd = d.x - mt;
            const float m2 = (a.y + b.y) + (c.y + d.y) + 64.0f * ((da * da + db * db) + (dc * dc + dd * dd));
            unsigned long long* slot = (unsigned long long*)xbuf + ((size_t)(u.pm * BM + row) * 4 + u.pn);
            __hip_atomic_store(slot, ((unsigned long long)__float_as_uint(m2) << 32) | __float_as_uint(mt), __ATOMIC_RELAXED, __HIP_MEMORY_SCOPE_AGENT);
        }
        asm volatile("s_waitcnt vmcnt(0)" ::: "memory");
        if (lane == 0) __hip_atomic_fetch_add(cnt + 64 * u.pm, 1u, __ATOMIC_RELAXED, __HIP_MEMORY_SCOPE_AGENT);
        if (wid == 0) {
            bool dead = false; const unsigned long long t0 = __builtin_amdgcn_s_memrealtime(); const unsigned want = 8u * (unsigned)ntn;
            for (;;) {
#if defined(BROKEN_EXCHANGE_NO_WAIT)
                break;
#endif
                if ((unsigned)__builtin_amdgcn_readfirstlane(__hip_atomic_load(cnt + 64 * u.pm, __ATOMIC_RELAXED, __HIP_MEMORY_SCOPE_AGENT)) >= want) break;
                if (__builtin_amdgcn_s_memrealtime() - t0 > 2000000ull) {
                    if (lane == 0) { unsigned expect = 0u; __hip_atomic_compare_exchange_strong(tmo + 1, &expect, code | (unsigned)(u.pm & 0xff), __ATOMIC_RELAXED, __ATOMIC_RELAXED, __HIP_MEMORY_SCOPE_AGENT);
                                     __hip_atomic_store(tmo, 1u, __ATOMIC_RELAXED, __HIP_MEMORY_SCOPE_AGENT); }
                    dead = true; break; }
                __builtin_amdgcn_s_sleep(2);
            }
            __builtin_amdgcn_fence(__ATOMIC_ACQUIRE, "agent");
            if (lane == 0) flag[0] = dead ? 1u : 0u;
        }
        asm volatile("s_waitcnt vmcnt(0) lgkmcnt(0)" ::: "memory"); __builtin_amdgcn_s_barrier(); asm volatile("" ::: "memory");
        const bool bad = flag[0] != 0u;
        if (lane < 32) {
            const unsigned long long* slot = (const unsigned long long*)xbuf + (size_t)(u.pm * BM + row) * 4; float mt[4], m2[4]; float ms = 0.f;
#pragma unroll
            for (int t = 0; t < 4; ++t) { if (t < ntn) { const unsigned long long w = __hip_atomic_load(slot + t, __ATOMIC_RELAXED, __HIP_MEMORY_SCOPE_AGENT); mt[t] = __uint_as_float((unsigned)w); m2[t] = __uint_as_float((unsigned)(w >> 32)); } else { mt[t] = 0.f; m2[t] = 0.f; } ms += mt[t]; }
            const float mean = ms / (float)ntn; float q = 0.f;
#pragma unroll
            for (int t = 0; t < 4; ++t) if (t < ntn) { const float dm = mt[t] - mean; q += m2[t] + 256.0f * dm * dm; }
            S[row] = (f32x2v){mean, 1.0f / sqrtf(q / (256.0f * (float)ntn) + eps)};
        }
        asm volatile("s_waitcnt lgkmcnt(0)" ::: "memory"); __builtin_amdgcn_s_barrier(); asm volatile("" ::: "memory");
        return bad;
    }
};
struct EpiLnRes {
    static constexpr bool PERM = false, AFTER_DRAIN = true;
    const float* base; float* out; int ldc; const float* bias; PanelStats st; unsigned poison;
    __device__ __forceinline__ void fused(f32x4 (&acc)[2][2][4][2], const Unit& u, int wr, int wc, int fr, int fq, PG8_LAS unsigned char* lds, int wid, int lane) const {
        typedef float f32x2v __attribute__((ext_vector_type(2)));
        const PG8_LAS f32x2v* S = (const PG8_LAS f32x2v*)(lds + 8192);
        const int col0 = u.pn * BM + wc * 32 + 4 * fq;
#pragma unroll
        for (int bj = 0; bj < 2; ++bj)
#pragma unroll
            for (int n = 0; n < 2; ++n) { const f32x4 bv = bias ? *(const f32x4*)(bias + col0 + bj * HALF + n * 16) : (f32x4){0.f, 0.f, 0.f, 0.f};
#pragma unroll
                for (int ai = 0; ai < 2; ++ai)
#pragma unroll
                    for (int m = 0; m < 4; ++m) acc[ai][bj][m][n] += bv; }
        f32x4 pre[4][2][2];
#pragma unroll
        for (int m = 0; m < 4; ++m) { const size_t off = (size_t)(u.pm * BM + wr * 64 + m * 16 + fr) * ldc + col0;
#pragma unroll
            for (int bj = 0; bj < 2; ++bj)
#pragma unroll
                for (int n = 0; n < 2; ++n) pre[m][bj][n] = *(const f32x4*)(base + off + bj * HALF + n * 16); }
        const bool bad = st.run(acc, u, wr, wc, fr, fq, lds, wid, lane) || poison != 0u;
        const float qnan = __builtin_nanf("");
#pragma unroll
        for (int ai = 0; ai < 2; ++ai)
#pragma unroll
            for (int m = 0; m < 4; ++m) { const int r = ai * HALF + wr * 64 + m * 16 + fr; const f32x2v sr = S[r]; const size_t off = (size_t)(u.pm * BM + r) * ldc + col0;
#pragma unroll
                for (int bj = 0; bj < 2; ++bj)
#pragma unroll
                    for (int n = 0; n < 2; ++n) { const f32x4 bs = ai == 0 ? pre[m][bj][n] : *(const f32x4*)(base + off + bj * HALF + n * 16); f32x4 o = bs + (acc[ai][bj][m][n] - sr.x) * sr.y;
                        if (bad) o = (f32x4){qnan, qnan, qnan, qnan}; *(f32x4*)(out + off + bj * HALF + n * 16) = o; }
                if (m & 1) asm volatile("" ::: "memory"); }
    }
};
struct EpiLnResLn {
    static constexpr bool PERM = false, AFTER_DRAIN = true;
    const float* base; float* out; bf16_t* xn; int ldc; const float* bias; PanelStats st1, st2; unsigned poison;
    __device__ __forceinline__ void fused(f32x4 (&acc)[2][2][4][2], const Unit& u, int wr, int wc, int fr, int fq, PG8_LAS unsigned char* lds, int wid, int lane) const {
        typedef float f32x2v __attribute__((ext_vector_type(2))); typedef unsigned u32x2v __attribute__((ext_vector_type(2)));
        const PG8_LAS f32x2v* S = (const PG8_LAS f32x2v*)(lds + 8192);
        const int col0 = u.pn * BM + wc * 32 + 4 * fq;
#pragma unroll
        for (int bj = 0; bj < 2; ++bj)
#pragma unroll
            for (int n = 0; n < 2; ++n) { const f32x4 bv = bias ? *(const f32x4*)(bias + col0 + bj * HALF + n * 16) : (f32x4){0.f, 0.f, 0.f, 0.f};
#pragma unroll
                for (int ai = 0; ai < 2; ++ai)
#pragma unroll
                    for (int m = 0; m < 4; ++m) acc[ai][bj][m][n] += bv; }
        bool bad = st1.run(acc, u, wr, wc, fr, fq, lds, wid, lane) || poison != 0u;
        const float qnan = __builtin_nanf("");
#pragma unroll
        for (int ai = 0; ai < 2; ++ai)
#pragma unroll
            for (int m = 0; m < 4; ++m) { const int r = ai * HALF + wr * 64 + m * 16 + fr; const f32x2v sr = S[r]; const size_t off = (size_t)(u.pm * BM + r) * ldc + col0;
#pragma unroll
                for (int bj = 0; bj < 2; ++bj)
#pragma unroll
                    for (int n = 0; n < 2; ++n) { const f32x4 bs = *(const f32x4*)(base + off + bj * HALF + n * 16); acc[ai][bj][m][n] = bs + (acc[ai][bj][m][n] - sr.x) * sr.y; }
                asm volatile("" : "+v"(acc[ai][0][m][0]), "+v"(acc[ai][0][m][1]), "+v"(acc[ai][1][m][0]), "+v"(acc[ai][1][m][1]));
                if (m & 1) asm volatile("" ::: "memory"); }
        const bool bad1 = bad;
        bad = st2.run(acc, u, wr, wc, fr, fq, lds, wid, lane) || bad;
#pragma unroll
        for (int ai = 0; ai < 2; ++ai)
#pragma unroll
            for (int m = 0; m < 4; ++m) { const int r = ai * HALF + wr * 64 + m * 16 + fr; const f32x2v sr = S[r]; const size_t off = (size_t)(u.pm * BM + r) * ldc + col0;
#pragma unroll
                for (int bj = 0; bj < 2; ++bj)
#pragma unroll
                    for (int n = 0; n < 2; ++n) { const f32x4 x1 = acc[ai][bj][m][n]; *(f32x4*)(out + off + bj * HALF + n * 16) = bad1 ? (f32x4){qnan, qnan, qnan, qnan} : x1;
                        const f32x4 o = (x1 - sr.x) * sr.y; u32x2v w; w.x = cvt_pk_bf16(o[0], o[1]); w.y = cvt_pk_bf16(o[2], o[3]);
                        if (bad) { w.x = 0x7fc07fc0u; w.y = 0x7fc07fc0u; } *(u32x2v*)(xn + off + bj * HALF + n * 16) = w; }
                asm volatile("" ::: "memory"); }
    }
};

template <class Epi, class Sched, bool ALIGN_EPI = false, bool SP2 = false>
__device__ __forceinline__ void gemm_phase(PG8_LAS unsigned char* lds, const Gemm g, const Sched& S, const Epi& E) {
    int tid_ = threadIdx.x; asm volatile("" : "+v"(tid_));
    const int tid = tid_, wid = __builtin_amdgcn_readfirstlane(tid >> 6), lane = tid & 63, wr = wid >> 2, wc = wid & 3, fr = lane & 15, fq = lane >> 4;
    const int K = g.K, nt = K / BK;
    unsigned voffA[2], voffB[2];
#pragma unroll
    for (int i = 0; i < 2; ++i) { int R, C; stage_rc(tid * 16 + i * 8192, R, C); const int Rb = Epi::PERM ? ((R & ~31) + perm32(R & 31)) : R;
        voffA[i] = (unsigned)(R * K + C) * 2u; voffB[i] = (unsigned)(Rb * K + C) * 2u; }
    const size_t kstep = (size_t)(BK * 2);
    const size_t hstep = (size_t)HALF * K * 2;
    const size_t tstep = 2 * hstep;
    const unsigned ldsw = (unsigned)wid * 1024u;
    const int aoff = lds_byte(wr * 64 + fr, fq * 8), boff = lds_byte(wc * 32 + fr, fq * 8);
#define PG8_SA(b, h) (((b) * 2 + (h)) * HTB)
#define PG8_SB(b, h) ((4 + (b) * 2 + (h)) * HTB)
#define PG8_STAGE(bufoff, gbase, voff) do { _Pragma("unroll") for (int _i = 0; _i < 2; ++_i) \
        __builtin_amdgcn_global_load_lds((const unsigned*)((const char*)(gbase) + (voff)[_i]), (PG8_LAS unsigned*)(lds + (bufoff) + ldsw + _i * 8192), 16, 0, 0); } while (0)
#define PG8_LDA(dst, b, h) do { _Pragma("unroll") for (int m = 0; m < 4; ++m) _Pragma("unroll") for (int k = 0; k < 2; ++k) dst[m][k] = *(const PG8_LAS bf16x8*)(lds + PG8_SA(b, h) + aoff + m * 2048 + k * 1024); } while (0)
#define PG8_LDB(dst, b, h) do { _Pragma("unroll") for (int n = 0; n < 2; ++n) _Pragma("unroll") for (int k = 0; k < 2; ++k) dst[n][k] = *(const PG8_LAS bf16x8*)(lds + PG8_SB(b, h) + boff + n * 2048 + k * 1024); } while (0)
#define PG8_MMA(ai, bj, At, Bt) do { __builtin_amdgcn_s_setprio(1); _Pragma("unroll") for (int m = 0; m < 4; ++m) _Pragma("unroll") for (int n = 0; n < 2; ++n) _Pragma("unroll") for (int k = 0; k < 2; ++k) \
        acc[ai][bj][m][n] = __builtin_amdgcn_mfma_f32_16x16x32_bf16(Bt[n][k], At[m][k], acc[ai][bj][m][n], 0, 0, 0); __builtin_amdgcn_s_setprio(0); } while (0)
#define PG8_WAIT_V(n) asm volatile("s_waitcnt vmcnt(" #n ")" ::: "memory")
#define PG8_WAIT_L(n) asm volatile("s_waitcnt lgkmcnt(" #n ")" ::: "memory")
#define PG8_BAR __builtin_amdgcn_s_barrier()
#define PG8_SCHED __builtin_amdgcn_sched_barrier(0)
    Unit cur, nxt; int ui = 0;
    if (!S.next(0, cur)) return;
    f32x4 acc[2][2][4][2];
#pragma unroll
    for (int a = 0; a < 2; ++a)
#pragma unroll
        for (int b = 0; b < 2; ++b)
#pragma unroll
            for (int m = 0; m < 4; ++m)
#pragma unroll
                for (int n = 0; n < 2; ++n) acc[a][b][m][n] = (f32x4){0.f, 0.f, 0.f, 0.f};
    bf16x8 At[4][2], B0[2][2], B1[2][2];
    const char* cA = (const char*)g.A + (size_t)cur.pm * tstep; const char* cB = (const char*)g.Bt + (size_t)cur.pn * tstep;
    S.a_ready(cur);
    if constexpr (SP2) {
        PG8_STAGE(PG8_SB(0, 0), cB, voffB); PG8_STAGE(PG8_SB(0, 1), cB + hstep, voffB); PG8_STAGE(PG8_SA(0, 0), cA, voffA); PG8_STAGE(PG8_SA(0, 1), cA + hstep, voffA);
        if (wr == 1) PG8_BAR;
        PG8_WAIT_V(2); PG8_BAR;
        PG8_STAGE(PG8_SB(1, 0), cB + kstep, voffB); PG8_STAGE(PG8_SA(1, 0), cA + kstep, voffA); PG8_STAGE(PG8_SB(1, 1), cB + hstep + kstep, voffB);
        PG8_WAIT_V(6); PG8_BAR;
    } else {
        PG8_STAGE(PG8_SB(0, 0), cB, voffB); PG8_STAGE(PG8_SA(0, 0), cA, voffA); PG8_STAGE(PG8_SB(0, 1), cB + hstep, voffB); PG8_STAGE(PG8_SA(0, 1), cA + hstep, voffA);
        if (wr == 1) PG8_BAR;
        PG8_WAIT_V(4); PG8_BAR;
        PG8_STAGE(PG8_SB(1, 0), cB + kstep, voffB); PG8_STAGE(PG8_SA(1, 0), cA + kstep, voffA); PG8_STAGE(PG8_SB(1, 1), cB + hstep + kstep, voffB);
        PG8_WAIT_V(6); PG8_BAR;
    }
    for (;;) {
        const bool has_next = S.next(ui + 1, nxt);
        const char* nA = has_next ? (const char*)g.A + (size_t)nxt.pm * tstep : cA; const char* nB = has_next ? (const char*)g.Bt + (size_t)nxt.pn * tstep : cB;
        for (int t = 0; t < nt; t += 2) {
            const bool last = (t == nt - 2);
            const char* a1 = cA + (size_t)(t + 1) * kstep;
            const char* a2 = last ? nA : cA + (size_t)(t + 2) * kstep; const char* b2 = last ? nB : cB + (size_t)(t + 2) * kstep;
            const char* a3 = a2 + kstep; const char* b3 = b2 + kstep;
            if (last && has_next) S.a_ready(nxt);
            if constexpr (SP2) {
            PG8_LDB(B0, 0, 0); PG8_LDB(B1, 0, 1); PG8_SCHED; PG8_LDA(At, 0, 0); PG8_STAGE(PG8_SA(1, 1), a1 + hstep, voffA);
            PG8_WAIT_V(8); PG8_WAIT_L(0); PG8_BAR; PG8_MMA(0, 0, At, B0); PG8_MMA(0, 1, At, B1); PG8_BAR; PG8_SCHED;
            PG8_LDA(At, 0, 1); PG8_STAGE(PG8_SB(0, 0), b2, voffB); PG8_STAGE(PG8_SB(0, 1), b2 + hstep, voffB); PG8_STAGE(PG8_SA(0, 0), a2, voffA);
            PG8_WAIT_V(8); PG8_WAIT_L(0); PG8_BAR; PG8_MMA(1, 0, At, B0); PG8_MMA(1, 1, At, B1); PG8_BAR; PG8_SCHED;
            PG8_LDB(B0, 1, 0); PG8_LDB(B1, 1, 1); PG8_SCHED; PG8_LDA(At, 1, 0); PG8_STAGE(PG8_SA(0, 1), a2 + hstep, voffA);
            PG8_WAIT_V(8); PG8_WAIT_L(0); PG8_BAR; PG8_MMA(0, 0, At, B0); PG8_MMA(0, 1, At, B1); PG8_BAR; PG8_SCHED;
            PG8_LDA(At, 1, 1); PG8_STAGE(PG8_SB(1, 0), b3, voffB); PG8_STAGE(PG8_SB(1, 1), b3 + hstep, voffB); PG8_STAGE(PG8_SA(1, 0), a3, voffA);
            PG8_WAIT_V(8); PG8_WAIT_L(0); PG8_BAR; PG8_MMA(1, 0, At, B0); PG8_MMA(1, 1, At, B1); PG8_BAR; PG8_SCHED;
            } else {
            PG8_LDB(B0, 0, 0); PG8_SCHED; PG8_LDA(At, 0, 0); PG8_STAGE(PG8_SA(1, 1), a1 + hstep, voffA);
            PG8_WAIT_L(8); PG8_BAR; PG8_WAIT_L(0); PG8_MMA(0, 0, At, B0); PG8_BAR; PG8_SCHED;
            PG8_LDB(B1, 0, 1); PG8_STAGE(PG8_SB(0, 0), b2, voffB);
            PG8_BAR; PG8_WAIT_L(0); PG8_MMA(0, 1, At, B1); PG8_BAR;
            PG8_LDA(At, 0, 1); PG8_STAGE(PG8_SA(0, 0), a2, voffA);
            PG8_BAR; PG8_WAIT_L(0); PG8_MMA(1, 0, At, B0); PG8_BAR; PG8_SCHED;
            PG8_STAGE(PG8_SB(0, 1), b2 + hstep, voffB);
            PG8_WAIT_V(6); PG8_BAR; PG8_MMA(1, 1, At, B1); PG8_BAR;
            PG8_LDB(B0, 1, 0); PG8_SCHED; PG8_LDA(At, 1, 0); PG8_STAGE(PG8_SA(0, 1), a2 + hstep, voffA);
            PG8_WAIT_L(8); PG8_BAR; PG8_WAIT_L(0); PG8_MMA(0, 0, At, B0); PG8_BAR; PG8_SCHED;
            PG8_LDB(B1, 1, 1); PG8_STAGE(PG8_SB(1, 0), b3, voffB);
            PG8_BAR; PG8_WAIT_L(0); PG8_MMA(0, 1, At, B1); PG8_BAR;
            PG8_LDA(At, 1, 1); PG8_STAGE(PG8_SA(1, 0), a3, voffA);
            PG8_BAR; PG8_WAIT_L(0); PG8_MMA(1, 0, At, B0); PG8_BAR; PG8_SCHED;
            PG8_STAGE(PG8_SB(1, 1), b3 + hstep, voffB);
            PG8_WAIT_V(6); PG8_BAR; PG8_MMA(1, 1, At, B1); PG8_BAR;
            }
        }
        if constexpr (ALIGN_EPI) { if (wr == 0) PG8_BAR; }
        if constexpr (!Epi::AFTER_DRAIN) { E(acc, cur, wr, wc, fr, fq); S.done(cur); }
        if (!has_next) break;
#pragma unroll
        for (int a = 0; a < 2; ++a)
#pragma unroll
            for (int b = 0; b < 2; ++b)
#pragma unroll
                for (int m = 0; m < 4; ++m)
#pragma unroll
                    for (int n = 0; n < 2; ++n) acc[a][b][m][n] = (f32x4){0.f, 0.f, 0.f, 0.f};
        cur = nxt; cA = nA; cB = nB; ++ui;
        if constexpr (ALIGN_EPI) { if (wr == 1) PG8_BAR; }
    }
    PG8_WAIT_V(0);
    if constexpr (!ALIGN_EPI) { if (wr == 0) PG8_BAR; }
    PG8_BAR;
    if constexpr (Epi::AFTER_DRAIN) { E.fused(acc, cur, wr, wc, fr, fq, lds, wid, lane); S.done(cur); }
#undef PG8_SA
#undef PG8_SB
#undef PG8_STAGE
#undef PG8_LDA
#undef PG8_LDB
#undef PG8_MMA
#undef PG8_WAIT_V
#undef PG8_WAIT_L
#undef PG8_BAR
#undef PG8_SCHED
}
}


namespace pg8 {
struct EpiProj {
    static constexpr bool PERM = true, AFTER_DRAIN = false;
    bf16_t* O; int ldc; const float* rs; const float* rope; unsigned rope_mask; unsigned qmask; float qscale; int rs_partial;
    __device__ __forceinline__ void operator()(const f32x4 (&acc)[2][2][4][2], const Unit& u, int wr, int wc, int fr, int fq) const {
        const int row0 = u.pm * BM + wr * 64 + fr; const int col0 = u.pn * BM + wc * 32 + 8 * fq;
        const bool roped = ((rope_mask >> u.pn) & 1u) && ((wc & 1) == 0); const float qs = ((qmask >> u.pn) & 1u) ? qscale : 1.f;
#pragma unroll
        for (int ai = 0; ai < 2; ++ai)
#pragma unroll
            for (int m = 0; m < 4; ++m) { const int row = row0 + ai * HALF + m * 16; float s;
                if (rs_partial) { const f32x4 q0 = *(const f32x4*)(rs + (size_t)row * 16), q1 = *(const f32x4*)(rs + (size_t)row * 16 + 4), q2 = *(const f32x4*)(rs + (size_t)row * 16 + 8), q3 = *(const f32x4*)(rs + (size_t)row * 16 + 12);
                    const f32x4 qq = (q0 + q1) + (q2 + q3); s = rsqrtf(((qq[0] + qq[1]) + (qq[2] + qq[3])) * (1.f / 1024.f) + 1e-6f) * qs; }
                else s = rs[row] * qs;
                bf16_t* rowp = O + (size_t)row * ldc + col0;
                f32x4 cs0 = {1.f, 1.f, 1.f, 1.f}, cs1 = cs0, sn0 = {0.f, 0.f, 0.f, 0.f}, sn1 = sn0;
                if (roped) { const float* rp = rope + (row & 2047) * 16; cs0 = *(const f32x4*)(rp); cs1 = *(const f32x4*)(rp + 4); sn0 = *(const f32x4*)(rp + 8); sn1 = *(const f32x4*)(rp + 12);
                    if (fq == 0) { sn0 = -sn0; sn1 = -sn1; } if (fq >= 2) { cs0 = (f32x4){1.f, 1.f, 1.f, 1.f}; cs1 = cs0; sn0 = (f32x4){0.f, 0.f, 0.f, 0.f}; sn1 = sn0; } }
#pragma unroll
                for (int bj = 0; bj < 2; ++bj) { f32x4 v0 = acc[ai][bj][m][0] * s, v1 = acc[ai][bj][m][1] * s;
                    if (roped) { f32x4 o0, o1;
#pragma unroll
                        for (int e = 0; e < 4; ++e) { o0[e] = __shfl_xor(v0[e], 16); o1[e] = __shfl_xor(v1[e], 16); }
                        v0 = v0 * cs0 + o0 * sn0; v1 = v1 * cs1 + o1 * sn1; }
                    u32x4 w; w.x = cvt_pk_bf16(v0[0], v0[1]); w.y = cvt_pk_bf16(v0[2], v0[3]); w.z = cvt_pk_bf16(v1[0], v1[1]); w.w = cvt_pk_bf16(v1[2], v1[3]);
                    *(u32x4*)(rowp + bj * HALF) = w; } }
    }
};
struct EpiResid {
    static constexpr bool PERM = true, AFTER_DRAIN = false;
    const float* base; float* out; bf16_t* ob; int ldc; float* ss;
    __device__ __forceinline__ void operator()(const f32x4 (&acc)[2][2][4][2], const Unit& u, int wr, int wc, int fr, int fq) const {
        const int row0 = u.pm * BM + wr * 64 + fr; const int col0 = u.pn * BM + wc * 32 + 8 * fq;
#pragma unroll
        for (int ai = 0; ai < 2; ++ai)
#pragma unroll
            for (int m = 0; m < 4; ++m) { const size_t off = (size_t)(row0 + ai * HALF + m * 16) * ldc + col0; float sq = 0.f;
#pragma unroll
                for (int bj = 0; bj < 2; ++bj) { const f32x4 b0 = *(const f32x4*)(base + off + bj * HALF), b1 = *(const f32x4*)(base + off + bj * HALF + 4);
                    const f32x4 v0 = b0 + acc[ai][bj][m][0], v1 = b1 + acc[ai][bj][m][1];
                    sq += (v0[0] * v0[0] + v0[1] * v0[1]) + (v0[2] * v0[2] + v0[3] * v0[3]) + (v1[0] * v1[0] + v1[1] * v1[1]) + (v1[2] * v1[2] + v1[3] * v1[3]);
                    *(f32x4*)(out + off + bj * HALF) = v0; *(f32x4*)(out + off + bj * HALF + 4) = v1;
                    if (ob) { u32x4 w; w.x = cvt_pk_bf16(v0[0], v0[1]); w.y = cvt_pk_bf16(v0[2], v0[3]); w.z = cvt_pk_bf16(v1[0], v1[1]); w.w = cvt_pk_bf16(v1[2], v1[3]); *(u32x4*)(ob + off + bj * HALF) = w; } }
                if (ss) { sq += __shfl_xor(sq, 16); sq += __shfl_xor(sq, 32); if (fq == 0) ss[(size_t)(row0 + ai * HALF + m * 16) * 16 + 4 * u.pn + wc] = sq; } }
    }
};
}

struct APlain { const bf16_t* A; int lda; __device__ __forceinline__ const bf16_t* operator()(int m, int k) const { return A + (size_t)m * lda + k; } };
struct ACmp { const bf16_t* act; int col0; __device__ __forceinline__ const bf16_t* operator()(int m, int k) const {
    const int g = m & 3, c0 = (m >> 2) & 127, b = m >> 9; const int c = c0 > 126 ? 126 : c0; const int l = k >> 6, d = k & 63;
    return act + (size_t)(b * SEQ + 16 * c + l) * N1 + col0 + g * 64 + d; } };

template <class AF, class Epi>
__device__ __forceinline__ void gemm_simple(const AF& af, const bf16_t* Bt, int ldb, int M, int N, int K, float* lds, const Epi& epi) {
    float* As = lds;
    float* Bs = lds + 128 * 33;
    const int tid = threadIdx.x, r = tid & 127, cgp = tid >> 7;
    const int tilesN = N / 64, ntiles = (M / 128) * tilesN;
    for (int tile = blockIdx.x; tile < ntiles; tile += gridDim.x) {
        const int tm = tile / tilesN, tn = tile % tilesN;
        float acc[16];
#pragma unroll
        for (int j = 0; j < 16; ++j) acc[j] = 0.f;
        for (int k0 = 0; k0 < K; k0 += 32) {
            __syncthreads();
            { const int ar = tid >> 2, ak = (tid & 3) * 8; const uint4 v = *(const uint4*)af(tm * 128 + ar, k0 + ak); float* d = As + ar * 33 + ak;
              d[0] = lo_f(v.x); d[1] = hi_f(v.x); d[2] = lo_f(v.y); d[3] = hi_f(v.y); d[4] = lo_f(v.z); d[5] = hi_f(v.z); d[6] = lo_f(v.w); d[7] = hi_f(v.w); }
            if (tid < 256) { const int bn = tid >> 2, bk = (tid & 3) * 8; const uint4 v = *(const uint4*)(Bt + (size_t)(tn * 64 + bn) * ldb + k0 + bk); float* d = Bs + bk * 64 + bn;
              d[0] = lo_f(v.x); d[64] = hi_f(v.x); d[128] = lo_f(v.y); d[192] = hi_f(v.y); d[256] = lo_f(v.z); d[320] = hi_f(v.z); d[384] = lo_f(v.w); d[448] = hi_f(v.w); }
            __syncthreads();
#pragma unroll 4
            for (int kk = 0; kk < 32; ++kk) {
                const float a = As[r * 33 + kk]; const float* bp = Bs + kk * 64 + cgp * 16;
#pragma unroll
                for (int j = 0; j < 16; ++j) acc[j] += a * bp[j];
            }
        }
        epi(tm * 128 + r, tn * 64 + cgp * 16, acc);
    }
}

namespace att {
typedef short bf16x8 __attribute__((ext_vector_type(8)));
typedef short s16x4 __attribute__((ext_vector_type(4)));
typedef float f32x16 __attribute__((ext_vector_type(16)));
typedef float f32x4 __attribute__((ext_vector_type(4)));
typedef unsigned u32x4 __attribute__((ext_vector_type(4)));
#define ALDS __attribute__((address_space(3)))
constexpr int SLOTB = 8192, L_K = 0, L_V = 2 * SLOTB, L_CB = 4 * SLOTB, L_WS = L_CB + 8192, L_OST = L_WS + 2048, L_END = L_OST + 65536;
constexpr float LOG2E = 1.4426950408889634f, C2 = 0.125f * LOG2E;
constexpr float THR = 8.f, NEGBIG = -1e30f, MINIT = -200.f;

__device__ __forceinline__ int crow(int r, int hi) { return (r & 3) + 8 * (r >> 2) + 4 * hi; }
__device__ __forceinline__ void glds16(const void* gsrc, unsigned lds_dst) { unsigned keep;
    asm volatile("s_mov_b32 %0, m0\n\ts_mov_b32 m0, %2\n\ts_nop 0\n\tglobal_load_lds_dwordx4 %1, off\n\ts_mov_b32 m0, %0" : "=&s"(keep) : "v"(gsrc), "s"(lds_dst) : "memory"); }
typedef float f32x2_t __attribute__((ext_vector_type(2))); typedef __bf16 bf16x2_t __attribute__((ext_vector_type(2)));
__device__ __forceinline__ unsigned cvtpk(float lo, float hi) { f32x2_t v = {lo, hi}; bf16x2_t b = __builtin_convertvector(v, bf16x2_t); return __builtin_bit_cast(unsigned, b); }
typedef short v4i16_t __attribute__((ext_vector_type(4)));
__device__ __forceinline__ s16x4 vtr(const ALDS char* p) { return __builtin_bit_cast(s16x4, __builtin_amdgcn_ds_read_tr16_b64_v4i16((ALDS v4i16_t*)p)); }

__device__ __forceinline__ void stage_tile(const bf16_t* Kt, const bf16_t* Vt, int pitch, unsigned kdst, unsigned vdst, int wid, int lane) {
    glds16(Kt + (size_t)lane * pitch + wid * 8, (unsigned)__builtin_amdgcn_readfirstlane(kdst + wid * 1024));
    glds16(Vt + (size_t)(16 * (wid & 3) + (lane >> 2)) * pitch + (wid >> 2) * 32 + (lane & 3) * 8, (unsigned)__builtin_amdgcn_readfirstlane(vdst + wid * 1024));
}
__device__ __forceinline__ void qkt(f32x16& p0, f32x16& p1, const ALDS char* Kslot, const bf16x8 (&qr)[4], const f32x16& c0, const f32x16& c1, int r32, int hi) {
    const ALDS char* kb = Kslot + hi * 1024 + r32 * 16;
#pragma unroll
    for (int d0 = 0; d0 < 4; ++d0) {
        const bf16x8 b0 = *(const ALDS bf16x8*)(kb + d0 * 2048), b1 = *(const ALDS bf16x8*)(kb + d0 * 2048 + 512);
        if (d0 == 0) { p0 = __builtin_amdgcn_mfma_f32_32x32x16_bf16(b0, qr[0], c0, 0, 0, 0); p1 = __builtin_amdgcn_mfma_f32_32x32x16_bf16(b1, qr[0], c1, 0, 0, 0); }
        else { p0 = __builtin_amdgcn_mfma_f32_32x32x16_bf16(b0, qr[d0], p0, 0, 0, 0); p1 = __builtin_amdgcn_mfma_f32_32x32x16_bf16(b1, qr[d0], p1, 0, 0, 0); } }
}
__device__ __forceinline__ float rowmax(const f32x16& p0, const f32x16& p1) {
    float a = fmaxf(p0[0], p1[0]), b = fmaxf(p0[1], p1[1]);
#pragma unroll
    for (int r = 2; r < 16; r += 2) { a = fmaxf(a, fmaxf(p0[r], p1[r])); b = fmaxf(b, fmaxf(p0[r + 1], p1[r + 1])); }
    const float m = fmaxf(a, b);
    return fmaxf(m, __shfl_xor(m, 32));
}
__device__ __forceinline__ void softmax_pv(f32x16& p0, f32x16& p1, const ALDS char* Vl, f32x16 (&o)[2], float& mhat, float& lsum, volatile ALDS float* wsf, int r32, int hi) {
    const float rm = rowmax(p0, p1);
    if (__any(rm > THR)) {
        const float dl = fmaxf(rm, 0.f); mhat += dl;
#pragma unroll
        for (int r = 0; r < 16; ++r) { p0[r] -= dl; p1[r] -= dl; }
        const float f = __builtin_amdgcn_exp2f(-dl); lsum *= f;
        if (hi == 0) wsf[r32] = f;
        asm volatile("s_waitcnt lgkmcnt(0)" ::: "memory");
#pragma unroll
        for (int r = 0; r < 16; ++r) { const float fr = wsf[crow(r, hi)]; o[0][r] *= fr; o[1][r] *= fr; }
    }
    float s0 = 0.f, s1 = 0.f;
#pragma unroll
    for (int r = 0; r < 16; ++r) { p0[r] = __builtin_amdgcn_exp2f(p0[r]); p1[r] = __builtin_amdgcn_exp2f(p1[r]); s0 += p0[r]; s1 += p1[r]; }
    lsum += s0 + s1;
    u32x4 pw0, pw1, pw2, pw3;
    pw0 = (u32x4){cvtpk(p0[0], p0[1]), cvtpk(p0[2], p0[3]), cvtpk(p0[4], p0[5]), cvtpk(p0[6], p0[7])};
    pw1 = (u32x4){cvtpk(p0[8], p0[9]), cvtpk(p0[10], p0[11]), cvtpk(p0[12], p0[13]), cvtpk(p0[14], p0[15])};
    pw2 = (u32x4){cvtpk(p1[0], p1[1]), cvtpk(p1[2], p1[3]), cvtpk(p1[4], p1[5]), cvtpk(p1[6], p1[7])};
    pw3 = (u32x4){cvtpk(p1[8], p1[9]), cvtpk(p1[10], p1[11]), cvtpk(p1[12], p1[13]), cvtpk(p1[14], p1[15])};
    const bf16x8 pa[4] = {__builtin_bit_cast(bf16x8, pw0), __builtin_bit_cast(bf16x8, pw1), __builtin_bit_cast(bf16x8, pw2), __builtin_bit_cast(bf16x8, pw3)};
#pragma unroll
    for (int d0 = 0; d0 < 2; ++d0)
#pragma unroll
        for (int ks = 0; ks < 4; ++ks) { const s16x4 lo = vtr(Vl + d0 * 4096 + ks * 1024), hh = vtr(Vl + d0 * 4096 + ks * 1024 + 512);
            const bf16x8 vf = {lo[0], lo[1], lo[2], lo[3], hh[0], hh[1], hh[2], hh[3]};
            o[d0] = __builtin_amdgcn_mfma_f32_32x32x16_bf16(pa[ks], vf, o[d0], 0, 0, 0); }
}

__device__ __forceinline__ void fox_unit(int b, int h, int qb, const bf16_t* act, const float* cum, bf16_t* ao, unsigned char* lds_generic) {
    int tid_ = threadIdx.x; asm volatile("" : "+v"(tid_));
    const int tid = tid_, lane = tid & 63, r32 = lane & 31, hi = lane >> 5; const int wid = __builtin_amdgcn_readfirstlane(tid >> 6);
    ALDS char* lds = (ALDS char*)lds_generic; const unsigned lds0 = (unsigned)(uintptr_t)lds;
    ALDS float* CB = (ALDS float*)(lds + L_CB); volatile ALDS float* wsf = (volatile ALDS float*)(lds + L_WS) + wid * 64; ALDS float* ost = (ALDS float*)(lds + L_OST) + wid * 2048;
    const int q0 = qb * 256, bh = b * 16 + h; const size_t rowbase = (size_t)b * 2048; constexpr int P = 4096;
    for (int i = tid; i < q0 + 256; i += 512) CB[i] = cum[(size_t)bh * 2048 + i] * LOG2E;
    const bf16_t* Qw = act + (rowbase + q0 + wid * 32) * P + h * 64;
    bf16x8 qr[4];
#pragma unroll
    for (int d0 = 0; d0 < 4; ++d0) qr[d0] = *(const bf16x8*)(Qw + (size_t)r32 * P + d0 * 16 + hi * 8);
    const bf16_t* Kh = act + rowbase * P + 1024 + h * 64; const bf16_t* Vh = Kh + 1024;
    const int NT = 4 * (qb + 1);
    stage_tile(Kh + (size_t)(NT - 1) * 64 * P, Vh + (size_t)(NT - 1) * 64 * P, P, lds0 + L_K, lds0 + L_V, wid, lane);
    float mhat = MINIT, lsum = 0.f; f32x16 o[2];
#pragma unroll
    for (int r = 0; r < 16; ++r) { o[0][r] = 0.f; o[1][r] = 0.f; }
    const int qfirst = q0 + wid * 32, qabs = qfirst + r32;
    const int vlane = ((lane >> 4) & 1) * 32 + (lane & 3) * 8 + (4 * hi + ((lane & 15) >> 2)) * 64;
    for (int it = 0; it < NT; ++it) {
        const int j = NT - 1 - it, slot = it & 1;
        asm volatile("s_waitcnt vmcnt(0)" ::: "memory"); __syncthreads();
        if (it + 1 < NT) stage_tile(Kh + (size_t)(j - 1) * 64 * P, Vh + (size_t)(j - 1) * 64 * P, P, lds0 + L_K + (slot ^ 1) * SLOTB, lds0 + L_V + (slot ^ 1) * SLOTB, wid, lane);
        if (64 * j <= qfirst + 31) {
            const float cbq = CB[qabs]; const float qoff = cbq - mhat; const ALDS float* cbt = CB + 64 * j + 4 * hi;
            f32x16 c0, c1, p0, p1;
#pragma unroll
            for (int i = 0; i < 4; ++i) { const f32x4 a = *(const ALDS f32x4*)(cbt + 8 * i), bb = *(const ALDS f32x4*)(cbt + 32 + 8 * i);
#pragma unroll
                for (int e = 0; e < 4; ++e) { c0[4 * i + e] = qoff - a[e]; c1[4 * i + e] = qoff - bb[e]; } }
            qkt(p0, p1, lds + L_K + slot * SLOTB, qr, c0, c1, r32, hi);
            if (64 * j + 63 > qfirst) { const int qrel = qabs - 64 * j;
#pragma unroll
                for (int r = 0; r < 16; ++r) { const int kv = crow(r, hi); if (kv > qrel) p0[r] = NEGBIG; if (kv + 32 > qrel) p1[r] = NEGBIG; } }
            softmax_pv(p0, p1, lds + L_V + slot * SLOTB + vlane, o, mhat, lsum, wsf, r32, hi);
        }
    }
    lsum += __shfl_xor(lsum, 32);
    const float invl = lsum > 0.f ? 1.f / lsum : 0.f;
    if (hi == 0) wsf[32 + r32] = invl;
    asm volatile("s_waitcnt lgkmcnt(0)" ::: "memory");
#pragma unroll
    for (int r = 0; r < 16; ++r) { const int orow = crow(r, hi); const float il = wsf[32 + orow]; ost[orow * 64 + r32] = o[0][r] * il; ost[orow * 64 + 32 + r32] = o[1][r] * il; }
    asm volatile("s_waitcnt lgkmcnt(0)" ::: "memory");
#pragma unroll
    for (int i = 0; i < 4; ++i) { const int row = i * 8 + (lane >> 3), ch = lane & 7;
        const f32x4 a = *(const ALDS f32x4*)(ost + row * 64 + ch * 8), c = *(const ALDS f32x4*)(ost + row * 64 + ch * 8 + 4);
        const size_t grow = rowbase + qfirst + row; const uint4 zz = *(const uint4*)(act + grow * P + 3072 + h * 64 + ch * 8);
        const float z[8] = {lo_f(zz.x), hi_f(zz.x), lo_f(zz.y), hi_f(zz.y), lo_f(zz.z), hi_f(zz.z), lo_f(zz.w), hi_f(zz.w)};
        const float v[8] = {a[0], a[1], a[2], a[3], c[0], c[1], c[2], c[3]}; u32 w[4];
#pragma unroll
        for (int e = 0; e < 4; ++e) w[e] = cvtpk(v[2 * e] * z[2 * e] * sigmoidf_(z[2 * e]), v[2 * e + 1] * z[2 * e + 1] * sigmoidf_(z[2 * e + 1]));
        *(uint4*)(ao + grow * 1024 + h * 64 + ch * 8) = make_uint4(w[0], w[1], w[2], w[3]); }
    asm volatile("s_waitcnt lgkmcnt(0)" ::: "memory"); __syncthreads();
}
__device__ __forceinline__ void nsa_tile_src(int it, int ncmp, int cur, int b, int g, const bf16_t* act, const bf16_t* kc, const bf16_t* vc, const bf16_t*& K, const bf16_t*& V, int& pitch) {
    if (it < ncmp) { const size_t o = ((size_t)(b * 128 + 64 * it) * 4 + g) * 64; K = kc + o; V = vc + o; pitch = 256; }
    else { int j; int ck, cv; if (it < ncmp + cur + 1) { j = cur - (it - ncmp); ck = C1_KS; cv = C1_VS; } else { j = cur - (it - ncmp - cur - 1); ck = C1_KW; cv = C1_VW; }
        const size_t o = ((size_t)b * 2048 + 64 * j) * N1 + g * 64; K = act + o + ck; V = act + o + cv; pitch = N1; }
}
__device__ __forceinline__ void branch_finish(f32x16 (&oacc)[2], const f32x16 (&o)[2], float lsum, float gate, volatile ALDS float* wsf, int r32, int hi) {
    const float l = lsum + __shfl_xor(lsum, 32);
    const float fac = l > 0.f ? gate / l : 0.f;
    if (hi == 0) wsf[32 + r32] = fac;
    asm volatile("s_waitcnt lgkmcnt(0)" ::: "memory");
#pragma unroll
    for (int r = 0; r < 16; ++r) { const float f = wsf[32 + crow(r, hi)]; oacc[0][r] += o[0][r] * f; oacc[1][r] += o[1][r] * f; }
    asm volatile("s_waitcnt lgkmcnt(0)" ::: "memory");
}
#define NSA_STEP_BEGIN() do { asm volatile("s_waitcnt vmcnt(0)" ::: "memory"); __syncthreads(); \
    if (it + 1 < NTU) { const bf16_t* K_; const bf16_t* V_; int pt_; nsa_tile_src(it + 1, ncmp, cur, b, g, act, kc, vc, K_, V_, pt_); \
        stage_tile(K_, V_, pt_, lds0 + L_K + ((it + 1) & 1) * SLOTB, lds0 + L_V + ((it + 1) & 1) * SLOTB, wid, lane); } } while (0)
#define NSA_RESET() do { mhat = MINIT; lsum = 0.f; _Pragma("unroll") for (int r_ = 0; r_ < 16; ++r_) { o[0][r_] = 0.f; o[1][r_] = 0.f; } } while (0)

__device__ __forceinline__ void nsa_unit(int b, int g, int tb, const bf16_t* act, const bf16_t* kc, const bf16_t* vc, bf16_t* ao, unsigned char* lds_generic) {
    int tid_ = threadIdx.x; asm volatile("" : "+v"(tid_));
    const int tid = tid_, lane = tid & 63, r32 = lane & 31, hi = lane >> 5; const int wid = __builtin_amdgcn_readfirstlane(tid >> 6);
    ALDS char* lds = (ALDS char*)lds_generic; const unsigned lds0 = (unsigned)(uintptr_t)lds;
    volatile ALDS float* wsf = (volatile ALDS float*)(lds + L_WS) + wid * 64; ALDS float* ost = (ALDS float*)(lds + L_OST) + wid * 2048;
    const int cur = tb, t0 = 64 * tb; const size_t rowbase = (size_t)b * 2048;
    const int ti = r32 & 7, hr = r32 >> 3, trel = 8 * wid + ti, t = t0 + trel, h = 4 * g + hr;
    const bf16_t* prow = act + (rowbase + t) * N1;
    bf16x8 qr[4];
#pragma unroll
    for (int d0 = 0; d0 < 4; ++d0) qr[d0] = *(const bf16x8*)(prow + h * 64 + d0 * 16 + hi * 8);
    const float gate_c = sigmoidf_(bf2f(prow[C1_GATE + h * 3])), gate_s = sigmoidf_(bf2f(prow[C1_GATE + h * 3 + 1])), gate_w = sigmoidf_(bf2f(prow[C1_GATE + h * 3 + 2]));
    const int ncmp = tb >= 16 ? 2 : 1, jlo = cur > 8 ? cur - 8 : 0, NTU = ncmp + (cur + 1) + (cur - jlo + 1);
    const int vlane = ((lane >> 4) & 1) * 32 + (lane & 3) * 8 + (4 * hi + ((lane & 15) >> 2)) * 64;
    { const bf16_t* K_; const bf16_t* V_; int pt_; nsa_tile_src(0, ncmp, cur, b, g, act, kc, vc, K_, V_, pt_); stage_tile(K_, V_, pt_, lds0 + L_K, lds0 + L_V, wid, lane); }
    float mhat, lsum; f32x16 o[2], oacc[2];
#pragma unroll
    for (int r = 0; r < 16; ++r) { oacc[0][r] = 0.f; oacc[1][r] = 0.f; }
    int it = 0;
    unsigned mymask;
    {   NSA_RESET();
        const int cmax_t = t >= 31 ? ((t - 31) >> 4) : -1;
        f32x16 sA0, sA1, sB0, sB1, zc;
#pragma unroll
        for (int r = 0; r < 16; ++r) { zc[r] = 0.f; sB0[r] = NEGBIG; sB1[r] = NEGBIG; }
        {   NSA_STEP_BEGIN();
            qkt(sA0, sA1, lds + L_K + (it & 1) * SLOTB, qr, zc, zc, r32, hi);
#pragma unroll
            for (int r = 0; r < 16; ++r) { const int c = crow(r, hi); if (c > cmax_t) sA0[r] = NEGBIG; if (c + 32 > cmax_t) sA1[r] = NEGBIG; }
            f32x16 p0, p1;
#pragma unroll
            for (int r = 0; r < 16; ++r) { p0[r] = sA0[r] - mhat; p1[r] = sA1[r] - mhat; }
            softmax_pv(p0, p1, lds + L_V + (it & 1) * SLOTB + vlane, o, mhat, lsum, wsf, r32, hi); ++it; }
        if (ncmp == 2) { NSA_STEP_BEGIN();
            qkt(sB0, sB1, lds + L_K + (it & 1) * SLOTB, qr, zc, zc, r32, hi);
#pragma unroll
            for (int r = 0; r < 16; ++r) { const int c = 64 + crow(r, hi); if (c > cmax_t) sB0[r] = NEGBIG; if (c + 32 > cmax_t) sB1[r] = NEGBIG; }
            f32x16 p0, p1;
#pragma unroll
            for (int r = 0; r < 16; ++r) { p0[r] = sB0[r] - mhat; p1[r] = sB1[r] - mhat; }
            softmax_pv(p0, p1, lds + L_V + (it & 1) * SLOTB + vlane, o, mhat, lsum, wsf, r32, hi); ++it; }
        branch_finish(oacc, o, lsum, gate_c, wsf, r32, hi);
        ALDS float* PS = ost; ALDS float* IMP = ost + 1024; ALDS unsigned* BITS = (ALDS unsigned*)(ost + 1280);
        const float lt = lsum + __shfl_xor(lsum, 32); const float inv = lt > 0.f ? 1.f / lt : 0.f;
#pragma unroll
        for (int r = 0; r < 16; ++r) { const int c = crow(r, hi);
            float a0 = __builtin_amdgcn_exp2f(sA0[r] - mhat) * inv, a1 = __builtin_amdgcn_exp2f(sA1[r] - mhat) * inv;
            a0 += __shfl_xor(a0, 8); a0 += __shfl_xor(a0, 16); a1 += __shfl_xor(a1, 8); a1 += __shfl_xor(a1, 16);
            if (r32 < 8) { PS[ti * 128 + c] = a0; PS[ti * 128 + 32 + c] = a1; }
            if (ncmp == 2) { float b0 = __builtin_amdgcn_exp2f(sB0[r] - mhat) * inv, b1 = __builtin_amdgcn_exp2f(sB1[r] - mhat) * inv;
                b0 += __shfl_xor(b0, 8); b0 += __shfl_xor(b0, 16); b1 += __shfl_xor(b1, 8); b1 += __shfl_xor(b1, 16);
                if (r32 < 8) { PS[ti * 128 + 64 + c] = b0; PS[ti * 128 + 96 + c] = b1; } } }
        asm volatile("s_waitcnt lgkmcnt(0)" ::: "memory");
        const int ti2 = lane & 7, jg = lane >> 3; float val[4];
#pragma unroll
        for (int k = 0; k < 4; ++k) { const int j = 4 * jg + k; float imp = 0.f;
            if (j <= cur) {
#pragma unroll
                for (int e = -1; e <= 3; ++e) { const int c = 4 * j + e; if (c >= 0 && c < 127) imp += PS[ti2 * 128 + c]; } }
            const bool forced = (j == 0) || (j == cur) || (j == cur - 1);
            val[k] = forced ? 1e6f : (j <= cur ? imp : -1.f); IMP[ti2 * 32 + j] = val[k]; }
        asm volatile("s_waitcnt lgkmcnt(0)" ::: "memory");
        unsigned bits = 0u; int rank[4] = {0, 0, 0, 0};
#pragma unroll
        for (int q4 = 0; q4 < 8; ++q4) { const f32x4 vv = *(const ALDS f32x4*)(IMP + ti2 * 32 + 4 * q4);
#pragma unroll
            for (int e = 0; e < 4; ++e) { const int jj = 4 * q4 + e; const float vj = vv[e];
#pragma unroll
                for (int k = 0; k < 4; ++k) { const int j = 4 * jg + k; rank[k] += ((vj > val[k]) || (vj == val[k] && jj < j)) ? 1 : 0; } } }
#pragma unroll
        for (int k = 0; k < 4; ++k) if (rank[k] < 8) bits |= 1u << (4 * jg + k);
        BITS[ti2 * 8 + jg] = bits;
        asm volatile("s_waitcnt lgkmcnt(0)" ::: "memory");
        mymask = 0u;
#pragma unroll
        for (int q8 = 0; q8 < 8; ++q8) mymask |= BITS[ti * 8 + q8];
        asm volatile("s_waitcnt lgkmcnt(0)" ::: "memory");
    }
    NSA_RESET();
    for (int j = cur; j >= 0; --j) { NSA_STEP_BEGIN();
        const bool mine = (mymask >> j) & 1u;
        if (__any(mine)) {
            f32x16 cm, p0, p1; const float nm = -mhat;
#pragma unroll
            for (int r = 0; r < 16; ++r) cm[r] = nm;
            qkt(p0, p1, lds + L_K + (it & 1) * SLOTB, qr, cm, cm, r32, hi);
            if (j == cur) {
#pragma unroll
                for (int r = 0; r < 16; ++r) { const int kv = crow(r, hi); if (kv > trel) p0[r] = NEGBIG; if (kv + 32 > trel) p1[r] = NEGBIG; } }
            if (!mine) {
#pragma unroll
                for (int r = 0; r < 16; ++r) { p0[r] = NEGBIG; p1[r] = NEGBIG; } }
            softmax_pv(p0, p1, lds + L_V + (it & 1) * SLOTB + vlane, o, mhat, lsum, wsf, r32, hi); }
        ++it; }
    branch_finish(oacc, o, lsum, gate_s, wsf, r32, hi);
    NSA_RESET();
    for (int j = cur; j >= jlo; --j) { NSA_STEP_BEGIN();
        f32x16 cm, p0, p1; const float nm = -mhat;
#pragma unroll
        for (int r = 0; r < 16; ++r) cm[r] = nm;
        qkt(p0, p1, lds + L_K + (it & 1) * SLOTB, qr, cm, cm, r32, hi);
        if (j == cur) {
#pragma unroll
            for (int r = 0; r < 16; ++r) { const int kv = crow(r, hi); if (kv > trel) p0[r] = NEGBIG; if (kv + 32 > trel) p1[r] = NEGBIG; } }
        if (j == cur - 8) {
#pragma unroll
            for (int r = 0; r < 16; ++r) { const int kv = crow(r, hi); if (kv <= trel) p0[r] = NEGBIG; if (kv + 32 <= trel) p1[r] = NEGBIG; } }
        softmax_pv(p0, p1, lds + L_V + (it & 1) * SLOTB + vlane, o, mhat, lsum, wsf, r32, hi);
        ++it; }
    branch_finish(oacc, o, lsum, gate_w, wsf, r32, hi);
#pragma unroll
    for (int r = 0; r < 16; ++r) { const int orow = crow(r, hi); ost[orow * 64 + r32] = oacc[0][r]; ost[orow * 64 + 32 + r32] = oacc[1][r]; }
    asm volatile("s_waitcnt lgkmcnt(0)" ::: "memory");
#pragma unroll
    for (int i = 0; i < 4; ++i) { const int row = i * 8 + (lane >> 3), ch = lane & 7; const int tok = t0 + 8 * wid + (row & 7), hh = 4 * g + (row >> 3);
        const f32x4 a = *(const ALDS f32x4*)(ost + row * 64 + ch * 8), c = *(const ALDS f32x4*)(ost + row * 64 + ch * 8 + 4);
        const size_t grow = rowbase + tok; const uint4 zz = *(const uint4*)(act + grow * N1 + C1_Z + hh * 64 + ch * 8);
        const float z[8] = {lo_f(zz.x), hi_f(zz.x), lo_f(zz.y), hi_f(zz.y), lo_f(zz.z), hi_f(zz.z), lo_f(zz.w), hi_f(zz.w)};
        const float v[8] = {a[0], a[1], a[2], a[3], c[0], c[1], c[2], c[3]}; u32 w[4];
#pragma unroll
        for (int e = 0; e < 4; ++e) w[e] = cvtpk(v[2 * e] * z[2 * e] * sigmoidf_(z[2 * e]), v[2 * e + 1] * z[2 * e + 1] * sigmoidf_(z[2 * e + 1]));
        *(uint4*)(ao + grow * 1024 + hh * 64 + ch * 8) = make_uint4(w[0], w[1], w[2], w[3]); }
    asm volatile("s_waitcnt lgkmcnt(0)" ::: "memory"); __syncthreads();
}
#undef NSA_STEP_BEGIN
#undef NSA_RESET
}

#define GAS __attribute__((address_space(1)))
#define LAS __attribute__((address_space(3)))
typedef unsigned v4u __attribute__((ext_vector_type(4)));
typedef GAS unsigned gu32;
typedef GAS unsigned long long gu64;
#define RLX_AGENT __ATOMIC_RELAXED, __HIP_MEMORY_SCOPE_AGENT
#define LDS_WAIT() asm volatile("s_waitcnt lgkmcnt(0)" ::: "memory")
#define VM_WAIT() asm volatile("s_waitcnt vmcnt(0)" ::: "memory")
__device__ __forceinline__ unsigned long long rt() { return __builtin_amdgcn_s_memrealtime(); }
__device__ __forceinline__ unsigned pk2(float lo, float hi) { return (unsigned)f2bf(lo) | ((unsigned)f2bf(hi) << 16); }

#define XB_TMO      128
#define XB_XCNT(j)  (256  + 64 * (j))
#define XB_XSUB(j)  (1280 + 64 * (j))
#define XB_XGEN(j)  (2304 + 64 * (j))
#define XB_TOP      3328
#define XB_TOPGEN   3392
#define XCD_BAR_WORDS 3456
#define XB_SPIN_CAP (1u << 18)

__device__ __forceinline__ unsigned xb_ld(unsigned* p)              { return __hip_atomic_load(p, __ATOMIC_RELAXED, __HIP_MEMORY_SCOPE_AGENT); }
__device__ __forceinline__ unsigned xb_add(unsigned* p, unsigned v) { return __hip_atomic_fetch_add(p, v, __ATOMIC_RELAXED, __HIP_MEMORY_SCOPE_AGENT); }
__device__ __forceinline__ unsigned xb_xcc_id() { return (unsigned)__builtin_amdgcn_s_getreg((3 << 11) | 20) & 0xFu; }
#define XB_SPIN(cond, bar) do { unsigned _sp = 0; while (cond) { __builtin_amdgcn_s_sleep(1); \
    if ((++_sp & 255u) == 0u) { if (xb_ld(&(bar)[XB_TMO])) break; if (_sp > XB_SPIN_CAP) { atomicAdd(&(bar)[XB_TMO], 1u); break; } } } } while (0)

struct XcdBarrier {
    unsigned* bar; unsigned x;
    volatile LAS unsigned* st;
};

__device__ __forceinline__ XcdBarrier xcd_barrier_post(unsigned* bar, volatile LAS unsigned* st) {
    XcdBarrier b; b.bar = bar; b.x = xb_xcc_id(); b.st = st;
    if (threadIdx.x == 0) (void)xb_add(&bar[XB_XCNT(b.x)], 1u);
    return b;
}
__device__ __forceinline__ void xcd_barrier_complete(unsigned* bar, unsigned x, unsigned& nloc, unsigned& nx) {
    const unsigned G = gridDim.x * gridDim.y * gridDim.z;
    unsigned sum, cnt, mine, sp = 0u;
    for (;;) {
        sum = 0u; cnt = 0u; mine = 0u;
#pragma unroll
        for (unsigned j = 0; j < 16; ++j) { const unsigned c = xb_ld(&bar[XB_XCNT(j)]); sum += c; cnt += (c > 0u) ? 1u : 0u; mine = (j == x) ? c : mine; }
        if (sum == G) break;
        __builtin_amdgcn_s_sleep(1);
        if ((++sp & 255u) == 0u) { if (xb_ld(&bar[XB_TMO])) break; if (sp > XB_SPIN_CAP) { atomicAdd(&bar[XB_TMO], 1u); break; } }
    }
    nloc = mine > 0u ? mine : 1u; nx = cnt > 0u ? cnt : 1u;
}

__device__ __forceinline__ void xcd_barrier(const XcdBarrier& b) {
    asm volatile("s_waitcnt vmcnt(0)" ::: "memory");
    __syncthreads();
    if (threadIdx.x == 0) {
        unsigned* bar = b.bar;
        __builtin_amdgcn_s_waitcnt(0);
        unsigned nloc = b.st[0], nx = b.st[1];
        if (nloc == 0u) { xcd_barrier_complete(bar, b.x, nloc, nx); b.st[0] = nloc; b.st[1] = nx; }
        const unsigned old = xb_add(&bar[XB_XSUB(b.x)], 1u);
        const unsigned gen = old / nloc;
        if (old + 1u == (gen + 1u) * nloc) {
            __builtin_amdgcn_fence(__ATOMIC_RELEASE, "agent");
            asm volatile("s_waitcnt vmcnt(0)" ::: "memory");
            const unsigned og = xb_add(&bar[XB_TOP], 1u);
            const unsigned tg = og / nx;
            if (og + 1u == (tg + 1u) * nx) xb_add(&bar[XB_TOPGEN], 1u);
            else XB_SPIN(xb_ld(&bar[XB_TOPGEN]) == tg, bar);
            __builtin_amdgcn_fence(__ATOMIC_ACQUIRE, "agent");
            xb_add(&bar[XB_XGEN(b.x)], 1u);
            asm volatile("s_waitcnt vmcnt(0)" ::: "memory");
        } else {
            XB_SPIN(xb_ld(&bar[XB_XGEN(b.x)]) == gen, bar);
            __builtin_amdgcn_fence(__ATOMIC_ACQUIRE, "agent");
            asm volatile("s_waitcnt vmcnt(0)" ::: "memory");
        }
    }
    __syncthreads();
}


template <class CMap>
__device__ __forceinline__ void p0_transpose_item(const float* W, int K, int N, int srcN, const CMap& cmap, const float* gain, bf16_t* WT, LAS float* scr, int item, int lane) {
    const int nblk = N / 32, kb = item / nblk, nb = item % nblk, k0 = 64 * kb, n0 = 32 * nb;
    const int sc = cmap(n0 + (lane & 31));
#pragma unroll 8
    for (int i = 0; i < 32; ++i) { const int kk = 2 * i + (lane >> 5); float v = 0.f; if (sc >= 0) { v = W[(size_t)(k0 + kk) * srcN + sc]; if (gain) v *= gain[k0 + kk]; } scr[kk * 33 + (lane & 31)] = v; }
    LDS_WAIT(); asm volatile("" ::: "memory");
    const int c = lane & 7;
#pragma unroll
    for (int j = 0; j < 4; ++j) { const int n = (lane >> 3) + 8 * j; const LAS float* sp = scr + (8 * c) * 33 + n;
        v4u o; o.x = pk2(sp[0 * 33], sp[1 * 33]); o.y = pk2(sp[2 * 33], sp[3 * 33]); o.z = pk2(sp[4 * 33], sp[5 * 33]); o.w = pk2(sp[6 * 33], sp[7 * 33]);
        *(GAS v4u*)(WT + (size_t)(n0 + n) * K + k0 + 8 * c) = o; }
    LDS_WAIT(); asm volatile("" ::: "memory");
}
struct CMapId { __device__ __forceinline__ int operator()(int n) const { return n; } };
struct CMapFox { __device__ __forceinline__ int operator()(int n) const { return n < 3072 ? n : n + 16; } };
struct CMapNsa { __device__ __forceinline__ int operator()(int n) const { return n < C1_Z ? n : (n < C1_GATE ? n + 48 : (n < C1_GATE + 48 ? n - 1024 : -1)); } };

namespace att {
__device__ __forceinline__ void cmp_unit(int kv, int tile, const bf16_t* act, const bf16_t* W1T, const float* cb, const bf16_t* W2T, const float* rope, bf16_t* dst, unsigned char* lds_generic) {
    int tid_ = threadIdx.x; asm volatile("" : "+v"(tid_));
    const int tid = tid_, lane = tid & 63, r32 = lane & 31, hi = lane >> 5; const int wid = __builtin_amdgcn_readfirstlane(tid >> 6);
    ALDS bf16_t* Hs = (ALDS bf16_t*)lds_generic;
    { const int m = tile * 32 + r32, g = m & 3, c0 = (m >> 2) & 127, b = m >> 9, c = c0 > 126 ? 126 : c0;
      const bf16_t* arow = act + ((size_t)b * 2048 + 16 * c) * N1 + (kv ? C1_VC : C1_KC) + g * 64 + hi * 8;
      const bf16_t* brow = W1T + (size_t)(wid * 32 + r32) * 2048 + hi * 8;
      f32x16 acc;
#pragma unroll
      for (int r = 0; r < 16; ++r) acc[r] = 0.f;
#pragma unroll 2
      for (int l = 0; l < 32; ++l) {
#pragma unroll
          for (int s4 = 0; s4 < 4; ++s4) { const bf16x8 a = *(const bf16x8*)(arow + (size_t)l * N1 + s4 * 16); const bf16x8 bb = *(const bf16x8*)(brow + l * 64 + s4 * 16);
              acc = __builtin_amdgcn_mfma_f32_32x32x16_bf16(a, bb, acc, 0, 0, 0); } }
      const float bias = cb[wid * 32 + r32];
#pragma unroll
      for (int r = 0; r < 16; ++r) { const float v = acc[r] + bias; Hs[crow(r, hi) * 264 + wid * 32 + r32] = f2bf(v * sigmoidf_(v)); } }
    asm volatile("s_waitcnt lgkmcnt(0)" ::: "memory"); __syncthreads();
    if (wid < 2) {
        f32x16 acc;
#pragma unroll
        for (int r = 0; r < 16; ++r) acc[r] = 0.f;
        const bf16_t* brow = W2T + (size_t)(wid * 32 + r32) * 256 + hi * 8;
#pragma unroll
        for (int ks = 0; ks < 16; ++ks) { const bf16x8 a = *(const ALDS bf16x8*)(Hs + r32 * 264 + ks * 16 + hi * 8); const bf16x8 bb = *(const bf16x8*)(brow + ks * 16);
            acc = __builtin_amdgcn_mfma_f32_32x32x16_bf16(a, bb, acc, 0, 0, 0); }
        const bool roped = (kv == 0) && (wid == 0);
#pragma unroll
        for (int r = 0; r < 16; ++r) { const int mrow = tile * 32 + crow(r, hi); float v = acc[r];
            if (roped) { const float other = __shfl_xor(v, 8); int c = (mrow >> 2) & 127; c = c > 126 ? 126 : c; const float* rp = rope + (16 * c + 31) * 16;
                if (r32 < 16) { const float cs = rp[r32 & 7], sn = rp[8 + (r32 & 7)]; v = v * cs + (r32 < 8 ? -other : other) * sn; } }
            dst[(size_t)mrow * 64 + wid * 32 + r32] = f2bf(v); }
    }
    __syncthreads();
}
}

__global__ void __launch_bounds__(512) fwd_kernel(Params p) {
    extern __shared__ __attribute__((aligned(16))) unsigned char lds_raw[];
    float* ldsf = (float*)lds_raw; pg8::PG8_LAS_T ldsL = (pg8::PG8_LAS_T)lds_raw;
    volatile LAS unsigned* MISC = (volatile LAS unsigned*)((LAS unsigned char*)lds_raw + 147456 - 64);
    if (threadIdx.x < 16) MISC[threadIdx.x] = 0u;
    __syncthreads();
    XcdBarrier bar = xcd_barrier_post((unsigned*)(p.ws + WS_CTL) + 4096, MISC);
    const int tid = threadIdx.x, lane = tid & 63, wib = tid >> 6;
    const int gtid = blockIdx.x * 512 + tid, gsz = gridDim.x * 512;
    const int gwave = blockIdx.x * 8 + wib, nwaves = gridDim.x * 8;

    const float* x = p.in[0]; const float* norm_g = p.in[1]; const float* fox_w_in = p.in[2]; const float* fox_b_f = p.in[3]; const float* fox_w_out = p.in[4];
    const float* nsa_w_in = p.in[5]; const float* pe_k = p.in[6]; const float* w_ck1 = p.in[7]; const float* w_ck2 = p.in[8];
    const float* pe_v = p.in[9]; const float* w_cv1 = p.in[10]; const float* w_cv2 = p.in[11]; const float* nsa_w_out = p.in[12]; const float* final_g = p.in[13];
    float* out = p.out; unsigned char* ws = p.ws;
    bf16_t* W0T = (bf16_t*)(ws + WS_W0T); bf16_t* WO0T = (bf16_t*)(ws + WS_WO0T); bf16_t* W1T = (bf16_t*)(ws + WS_W1T); bf16_t* WO1T = (bf16_t*)(ws + WS_WO1T);
    bf16_t* WCK1T = (bf16_t*)(ws + WS_WCK1T); bf16_t* WCV1T = (bf16_t*)(ws + WS_WCV1T); bf16_t* WCK2T = (bf16_t*)(ws + WS_WCK2T); bf16_t* WCV2T = (bf16_t*)(ws + WS_WCV2T);
    float* CBIAS = (float*)(ws + WS_CBIAS); float* ROPE = (float*)(ws + WS_ROPE); float* RS0 = (float*)(ws + WS_RS0); float* RS1 = (float*)(ws + WS_RS1);
    float* SS1 = (float*)(ws + WS_HID); float* LOGF = (float*)(ws + WS_LOGF); float* CUM = (float*)(ws + WS_CUM);
    bf16_t* KC = (bf16_t*)(ws + WS_KC); bf16_t* VC = (bf16_t*)(ws + WS_VC); bf16_t* HID = (bf16_t*)(ws + WS_HID);
    bf16_t* XB = (bf16_t*)(ws + WS_XB); bf16_t* ACT = (bf16_t*)(ws + WS_ACT); bf16_t* AO = (bf16_t*)(ws + WS_AO);
    const float* g0 = norm_g; const float* g1 = norm_g + DM;

    { LAS float* scr = (LAS float*)((LAS unsigned char*)lds_raw + 65536) + wib * (64 * 33);
      LAS float* wfT = (LAS float*)((LAS unsigned char*)lds_raw);
      for (int k = tid; k < DM; k += 512) { const float gg = g0[k]; const float* wp = fox_w_in + (size_t)k * FOX_IN + 3072;
#pragma unroll
          for (int hq = 0; hq < 4; ++hq) { const float4 w4 = *(const float4*)(wp + 4 * hq); wfT[(4 * hq + 0) * DM + k] = gg * w4.x; wfT[(4 * hq + 1) * DM + k] = gg * w4.y; wfT[(4 * hq + 2) * DM + k] = gg * w4.z; wfT[(4 * hq + 3) * DM + k] = gg * w4.w; } }
      constexpr int I0 = (DM / 64) * (N0 / 32), I1 = (DM / 64) * (N1 / 32), IO = (DM / 64) * (DM / 32), IC1 = (2048 / 64) * (256 / 32), IC2 = (256 / 64) * (64 / 32);
      constexpr int NITEMS = I0 + I1 + 2 * IO + 2 * IC1 + 2 * IC2;
      for (int it = gwave; it < NITEMS; it += nwaves) { int r = it;
          if (r < I0) { p0_transpose_item(fox_w_in, DM, N0, FOX_IN, CMapFox{}, g0, W0T, scr, r, lane); continue; } r -= I0;
          if (r < I1) { p0_transpose_item(nsa_w_in, DM, N1, NSA_IN, CMapNsa{}, g1, W1T, scr, r, lane); continue; } r -= I1;
          if (r < IO) { p0_transpose_item(fox_w_out, DM, DM, DM, CMapId{}, (const float*)nullptr, WO0T, scr, r, lane); continue; } r -= IO;
          if (r < IO) { p0_transpose_item(nsa_w_out, DM, DM, DM, CMapId{}, (const float*)nullptr, WO1T, scr, r, lane); continue; } r -= IO;
          if (r < IC1) { p0_transpose_item(w_ck1, 2048, 256, 256, CMapId{}, (const float*)nullptr, WCK1T, scr, r, lane); continue; } r -= IC1;
          if (r < IC1) { p0_transpose_item(w_cv1, 2048, 256, 256, CMapId{}, (const float*)nullptr, WCV1T, scr, r, lane); continue; } r -= IC1;
          if (r < IC2) { p0_transpose_item(w_ck2, 256, 64, 64, CMapId{}, (const float*)nullptr, WCK2T, scr, r, lane); continue; } r -= IC2;
          p0_transpose_item(w_cv2, 256, 64, 64, CMapId{}, (const float*)nullptr, WCV2T, scr, r, lane); }
      for (int i = gtid; i < SEQ * 8; i += gsz) { const int pos = i >> 3, j = i & 7; const double inv = pow(500000.0, -(double)j / 8.0); const double a = (double)pos * inv;
          ROPE[pos * 16 + j] = (float)cos(a); ROPE[pos * 16 + 8 + j] = (float)sin(a); }
      for (int o = gwave; o < 512; o += nwaves) { const int kv = o >> 8, n = o & 255; const float* pe = kv ? pe_v : pe_k; const float* w1 = kv ? w_cv1 : w_ck1; float sacc = 0.f;
          for (int k = lane; k < 2048; k += 64) sacc += pe[k] * w1[(size_t)k * 256 + n];
          sacc = wave_sum(sacc); if (lane == 0) CBIAS[o] = sacc; }
      __syncthreads();
      for (int row = gwave; row < MTOK; row += nwaves) {
          const float* xr = x + (size_t)row * DM; float4 v[4]; float ss = 0.f;
#pragma unroll
          for (int j = 0; j < 4; ++j) { v[j] = *(const float4*)(xr + j * 256 + lane * 4); ss += v[j].x * v[j].x + v[j].y * v[j].y + v[j].z * v[j].z + v[j].w * v[j].w; }
          ss = wave_sum(ss); const float rstd = rsqrtf(ss * (1.f / DM) + EPS);
          if (lane == 0) RS0[row] = rstd;
#pragma unroll
          for (int j = 0; j < 4; ++j) { uint2 w; w.x = pk2(v[j].x, v[j].y); w.y = pk2(v[j].z, v[j].w); *(uint2*)(XB + (size_t)row * DM + j * 256 + lane * 4) = w; }
          float myf = 0.f;
#pragma unroll 2
          for (int h = 0; h < NH; ++h) { float sacc = 0.f;
#pragma unroll
              for (int j = 0; j < 4; ++j) { const att::f32x4 w4 = *(const LAS att::f32x4*)(wfT + h * DM + j * 256 + lane * 4); sacc += v[j].x * w4[0] + v[j].y * w4[1] + v[j].z * w4[2] + v[j].w * w4[3]; }
              sacc = wave_sum(sacc); if (lane == h) myf = sacc; }
          if (lane < NH) { const float f = myf * rstd + fox_b_f[lane]; LOGF[row * 16 + lane] = fminf(f, 0.f) - log1pf(expf(-fabsf(f))); }
      }
      __syncthreads(); }
    xcd_barrier(bar);

    { pg8::Gemm g{XB, W0T, MTOK, N0, DM}; pg8::StaticOrder S; S.init(MTOK, N0, (int)gridDim.x, (int)blockIdx.x);
      pg8::EpiProj E{ACT, N0, RS0, ROPE, 0u, 0xFu, att::C2, 0};
      pg8::gemm_phase<pg8::EpiProj, pg8::StaticOrder, true, true>(ldsL, g, S, E); }
    for (int bh = gwave; bh < BATCH * NH; bh += nwaves) { const int b = bh >> 4, h = bh & 15; float loc = 0.f;
        for (int i = 0; i < 32; ++i) loc += LOGF[(size_t)(b * SEQ + lane * 32 + i) * 16 + h];
        float inc = loc;
#pragma unroll
        for (int o = 1; o < 64; o <<= 1) { const float t = __shfl_up(inc, o); if (lane >= o) inc += t; }
        float run = inc - loc;
        for (int i = 0; i < 32; ++i) { run += LOGF[(size_t)(b * SEQ + lane * 32 + i) * 16 + h]; CUM[(size_t)bh * SEQ + lane * 32 + i] = run; } }
    xcd_barrier(bar);

    { const int G = (int)gridDim.x; const int vcu = (G % 8 == 0) ? ((int)blockIdx.x % 8) * (G / 8) + (int)blockIdx.x / 8 : (int)blockIdx.x;
      for (int gi = vcu; gi < 256; gi += G) { const int bh = gi >> 1, half = gi & 1;
          for (int i = 0; i < 4; ++i) { const int qb = half ? (i == 0 ? 2 : i == 1 ? 5 : i == 2 ? 3 : 4) : (i == 0 ? 0 : i == 1 ? 7 : i == 2 ? 1 : 6);
              att::fox_unit(bh >> 4, bh & 15, qb, ACT, CUM, AO, lds_raw); } } }
    xcd_barrier(bar);

    { pg8::Gemm g{AO, WO0T, MTOK, DM, DM}; pg8::StaticOrder S; S.init(MTOK, DM, (int)gridDim.x, (int)blockIdx.x);
      pg8::EpiResid E{x, out, XB, DM, SS1};
      pg8::gemm_phase<pg8::EpiResid, pg8::StaticOrder, true, true>(ldsL, g, S, E); }
    xcd_barrier(bar);

    { pg8::Gemm g{XB, W1T, MTOK, N1, DM}; pg8::StaticOrder S; S.init(MTOK, N1, (int)gridDim.x, (int)blockIdx.x);
      pg8::EpiProj E{ACT, N1, SS1, ROPE, 0x14Fu, 0xFu, att::C2, 1};
      pg8::gemm_phase<pg8::EpiProj, pg8::StaticOrder, true, true>(ldsL, g, S, E); }
    xcd_barrier(bar);

    for (int u = blockIdx.x; u < 256; u += gridDim.x) { const int kv = u >> 7, tile = u & 127;
        att::cmp_unit(kv, tile, ACT, kv ? WCV1T : WCK1T, CBIAS + kv * 256, kv ? WCV2T : WCK2T, ROPE, kv ? VC : KC, lds_raw); }
    xcd_barrier(bar);

    { const int G = (int)gridDim.x; const int vcu = (G % 8 == 0) ? ((int)blockIdx.x % 8) * (G / 8) + (int)blockIdx.x / 8 : (int)blockIdx.x;
      for (int gi = vcu; gi < 256; gi += G) { const int bg = gi >> 3, pp = gi & 7;
          for (int i = 0; i < 4; ++i) { const int tb = i == 0 ? 31 - pp : i == 1 ? 16 + pp : i == 2 ? 15 - pp : pp;
              att::nsa_unit(bg >> 2, bg & 3, tb, ACT, KC, VC, AO, lds_raw); } } }
    xcd_barrier(bar);

    { pg8::Gemm g{AO, WO1T, MTOK, DM, DM}; pg8::StaticOrder S; S.init(MTOK, DM, (int)gridDim.x, (int)blockIdx.x);
      pg8::EpiResid E{out, out, nullptr, DM, nullptr};
      pg8::gemm_phase<pg8::EpiResid, pg8::StaticOrder, true, true>(ldsL, g, S, E); }
    xcd_barrier(bar);
    for (int row = gwave; row < MTOK; row += nwaves) { float* xr = out + (size_t)row * DM; float4 v[4]; float ss = 0.f;
#pragma unroll
        for (int j = 0; j < 4; ++j) { v[j] = *(const float4*)(xr + j * 256 + lane * 4); ss += v[j].x * v[j].x + v[j].y * v[j].y + v[j].z * v[j].z + v[j].w * v[j].w; }
        ss = wave_sum(ss); const float rstd = rsqrtf(ss * (1.f / DM) + EPS);
#pragma unroll
        for (int j = 0; j < 4; ++j) { const float4 gg = *(const float4*)(final_g + j * 256 + lane * 4); float4 o; o.x = v[j].x * rstd * gg.x; o.y = v[j].y * rstd * gg.y; o.z = v[j].z * rstd * gg.z; o.w = v[j].w * rstd * gg.w; *(float4*)(xr + j * 256 + lane * 4) = o; } }
}

extern "C" void kernel_launch(void* const* d_in, const int* in_sizes, int n_in, void* d_out, int out_size, void* d_ws, size_t ws_size, hipStream_t stream) {
    constexpr size_t kDynLds = 147456;
    static int grid_blocks = 0;
    if (!grid_blocks) {
        int dev = 0, cus = 0, per_cu = 0;
        hipGetDevice(&dev);
        hipDeviceGetAttribute(&cus, hipDeviceAttributeMultiprocessorCount, dev);
        hipFuncSetAttribute((const void*)fwd_kernel, hipFuncAttributeMaxDynamicSharedMemorySize, (int)kDynLds);
        hipOccupancyMaxActiveBlocksPerMultiprocessor(&per_cu, (const void*)fwd_kernel, 512, kDynLds);
        if (per_cu < 1) per_cu = 1;
        if (per_cu > 1) per_cu = 1;
        grid_blocks = cus * per_cu;
        if (n_in != 14 || ws_size < WS_END) fprintf(stderr, "kernel_launch: unexpected n_in %d / ws_size %zu\n", n_in, ws_size);
    }
    hipMemsetAsync((char*)d_ws + WS_CTL, 0, 65536, stream);
    Params p{};
    for (int i = 0; i < 14; ++i) p.in[i] = (const float*)d_in[i];
    p.out = (float*)d_out; p.ws = (unsigned char*)d_ws;
    void* args[] = {&p};
    hipError_t e = hipLaunchCooperativeKernel((const void*)fwd_kernel, dim3(grid_blocks), dim3(512), args, kDynLds, stream);
    if (e != hipSuccess) fprintf(stderr, "cooperative launch failed: %s (grid %d)\n", hipGetErrorString(e), grid_blocks);
}
```
